# Optimizing an MI355X kernel written in HIP

```python
import jax, jax.numpy as jnp
from jax import lax
import numpy as np

D_MODEL = 2048
BATCH = 2
SEQ = 8192
DEPTH = 4

D_MIX = D_MODEL
W_POOL = D_MIX // 4
W_CONV = D_MIX // 4
W_SGU = D_MIX // 4
W_SSM = D_MIX - W_POOL - W_CONV - W_SGU
POOL_WINDOWS = (2, 4, 8, 16)
POOL_GROUP = W_POOL // len(POOL_WINDOWS)
CONV_WIDTH = 31
SGU_CHUNK = 128
SGU_HEADS = 4
SGU_HEAD_DIM = W_SGU // SGU_HEADS
SSM_HEAD_DIM = 64
SSM_HEADS = W_SSM // SSM_HEAD_DIM
SSM_GROUPS = 2
SSM_STATE = 128
SSM_CONV = 4
SSM_CHUNK = 128
SSM_CONV_DIM = W_SSM + 2 * SSM_GROUPS * SSM_STATE
D_FF = ((8 * D_MODEL // 3 + 255) // 256) * 256
IN_SIZES = (W_POOL, W_CONV, W_CONV, W_SGU, W_SGU, W_SSM, SSM_CONV_DIM, SSM_HEADS)
IN_COLS = sum(IN_SIZES)
EPS = 1e-6

kernel_name = "hybrid_parallel_pool_conv_sgu_ssd_macaron"


def rmsnorm(x, g):
    xf = x.astype(jnp.float32)
    y = xf * lax.rsqrt(jnp.mean(xf * xf, axis=-1, keepdims=True) + EPS)
    return (y * g.astype(jnp.float32)).astype(x.dtype)


def layernorm(x, g, b):
    xf = x.astype(jnp.float32)
    mu = jnp.mean(xf, axis=-1, keepdims=True)
    var = jnp.mean(jnp.square(xf - mu), axis=-1, keepdims=True)
    y = (xf - mu) * lax.rsqrt(var + EPS)
    return (y * g.astype(jnp.float32) + b.astype(jnp.float32)).astype(x.dtype)


def swiglu(h, w_gate, w_up, w_down):
    return (jax.nn.silu(h @ w_gate) * (h @ w_up)) @ w_down


def causal_depthwise_conv(x, w, b):
    k, c = w.shape
    y = lax.conv_general_dilated(
        x, w[:, None, :].astype(x.dtype), window_strides=(1,), padding=[(k - 1, 0)],
        dimension_numbers=("NWC", "WIO", "NWC"), feature_group_count=c)
    return y + b


def pool_mixer(a, w, scale):
    bsz, s, _ = a.shape
    af = a.astype(jnp.float32).reshape(bsz, s, len(POOL_WINDOWS), POOL_GROUP)
    cs = jnp.cumsum(af, axis=1)
    outs = []
    for g, win in enumerate(POOL_WINDOWS):
        c = cs[:, :, g]
        shifted = jnp.pad(c, ((0, 0), (win, 0), (0, 0)))[:, :s]
        count = jnp.minimum(jnp.arange(1, s + 1), win).astype(jnp.float32)[None, :, None]
        outs.append((c - shifted) / count - af[:, :, g])
    p = jnp.stack(outs, axis=2).astype(a.dtype)
    y = jnp.einsum("bsgc,gcd->bsgd", p, w).reshape(bsz, s, W_POOL)
    return y * scale


def conv_module(val, gate, dw_w, dw_b, ln_g, ln_b, pw_w, pw_b):
    h = val * jax.nn.sigmoid(gate)
    h = causal_depthwise_conv(h, dw_w, dw_b)
    h = jax.nn.silu(layernorm(h, ln_g, ln_b))
    return h @ pw_w + pw_b


def sgu_mixer(u, v, ln_g, ln_b, w_s, b_s):
    bsz, s, _ = u.shape
    u = jax.nn.gelu(u)
    v = layernorm(jax.nn.gelu(v), ln_g, ln_b)
    nc = s // SGU_CHUNK
    vc = v.reshape(bsz, nc, SGU_CHUNK, SGU_HEADS, SGU_HEAD_DIM)
    mask = jnp.tril(jnp.ones((SGU_CHUNK, SGU_CHUNK), dtype=bool))
    ws = jnp.where(mask, w_s, jnp.zeros_like(w_s))
    g = jnp.einsum("hts,bcshd->bcthd", ws, vc) + b_s.T[None, None, :, :, None]
    return u * g.reshape(bsz, s, W_SGU)


def ssd_mixer(z, xbc, dt_raw, conv_w, conv_b, dt_bias, a_log, d_skip, norm_g):
    bsz, s, _ = z.shape
    H, P, N, Q = SSM_HEADS, SSM_HEAD_DIM, SSM_STATE, SSM_CHUNK
    rep = SSM_HEADS // SSM_GROUPS
    xbc = jax.nn.silu(causal_depthwise_conv(xbc, conv_w, conv_b))
    xs, bm, cm = jnp.split(xbc, [W_SSM, W_SSM + SSM_GROUPS * N], axis=-1)
    xs = xs.astype(jnp.float32).reshape(bsz, s, H, P)
    bm = jnp.repeat(bm.astype(jnp.float32).reshape(bsz, s, SSM_GROUPS, N), rep, axis=2)
    cm = jnp.repeat(cm.astype(jnp.float32).reshape(bsz, s, SSM_GROUPS, N), rep, axis=2)
    dt = jax.nn.softplus(dt_raw.astype(jnp.float32) + dt_bias.astype(jnp.float32))
    a = -jnp.exp(a_log.astype(jnp.float32))
    nc = s // Q
    x_c = (xs * dt[..., None]).reshape(bsz, nc, Q, H, P)
    b_c = bm.reshape(bsz, nc, Q, H, N)
    c_c = cm.reshape(bsz, nc, Q, H, N)
    a_cs = jnp.cumsum((dt * a).reshape(bsz, nc, Q, H).transpose(0, 3, 1, 2), axis=-1)
    mask = jnp.tril(jnp.ones((Q, Q), dtype=bool))
    seg = a_cs[..., :, None] - a_cs[..., None, :]
    decay = jnp.where(mask, jnp.exp(jnp.where(mask, seg, 0.0)), 0.0)
    scores = jnp.einsum("bclhn,bcshn->bhcls", c_c, b_c) * decay
    y_diag = jnp.einsum("bhcls,bcshp->bclhp", scores, x_c)
    decay_states = jnp.exp(a_cs[..., -1:] - a_cs)
    states = jnp.einsum("bclhn,bhcl,bclhp->bchpn", b_c, decay_states, x_c)
    chunk_decay = jnp.exp(a_cs[..., -1])

    def step(hstate, inp):
        s_c, dec_c = inp
        return hstate * dec_c[..., None, None] + s_c, hstate

    h0 = jnp.zeros((bsz, H, P, N), jnp.float32)
    _, prev = lax.scan(step, h0, (states.transpose(1, 0, 2, 3, 4), chunk_decay.transpose(2, 0, 1)))
    prev = prev.transpose(1, 0, 2, 3, 4)
    y_off = jnp.einsum("bclhn,bchpn,bhcl->bclhp", c_c, prev, jnp.exp(a_cs))
    y = (y_diag + y_off).reshape(bsz, s, H, P) + xs * d_skip.astype(jnp.float32)[:, None]
    y = y.reshape(bsz, s, W_SSM) * jax.nn.silu(z.astype(jnp.float32))
    yg = y.reshape(bsz, s, SSM_GROUPS, W_SSM // SSM_GROUPS)
    yg = yg * lax.rsqrt(jnp.mean(yg * yg, axis=-1, keepdims=True) + EPS)
    return (yg.reshape(bsz, s, W_SSM) * norm_g.astype(jnp.float32)).astype(z.dtype)


def setup_inputs(seed: int = 0) -> dict:
    key = jax.random.key(seed)
    ks = iter(jax.random.split(key, 40))
    f32 = jnp.float32

    def dense(shape, fan_in):
        return jax.random.normal(next(ks), shape, f32) * (fan_in ** -0.5)

    def gain(shape):
        return 1.0 + 0.02 * jax.random.normal(next(ks), shape, f32)

    def bias(shape):
        return 0.02 * jax.random.normal(next(ks), shape, f32)

    L = DEPTH
    x = jax.random.normal(next(ks), (BATCH, SEQ, D_MODEL), f32)
    ffn1_norm = gain((L, D_MODEL))
    ffn1_w_gate = dense((L, D_MODEL, D_FF), D_MODEL)
    ffn1_w_up = dense((L, D_MODEL, D_FF), D_MODEL)
    ffn1_w_down = dense((L, D_FF, D_MODEL), D_FF)
    mix_norm = gain((L, D_MODEL))
    w_in = dense((L, D_MODEL, IN_COLS), D_MODEL)
    pool_w = dense((L, len(POOL_WINDOWS), POOL_GROUP, POOL_GROUP), POOL_GROUP)
    pool_scale = 1.0 + 0.1 * jax.random.normal(next(ks), (L, W_POOL), f32)
    conv_dw_w = dense((L, CONV_WIDTH, W_CONV), CONV_WIDTH)
    conv_dw_b = bias((L, W_CONV))
    conv_ln_g = gain((L, W_CONV))
    conv_ln_b = bias((L, W_CONV))
    conv_pw_w = dense((L, W_CONV, W_CONV), W_CONV)
    conv_pw_b = bias((L, W_CONV))
    sgu_ln_g = gain((L, W_SGU))
    sgu_ln_b = bias((L, W_SGU))
    sgu_w_s = dense((L, SGU_HEADS, SGU_CHUNK, SGU_CHUNK), SGU_CHUNK)
    sgu_b = gain((L, SGU_HEADS, SGU_CHUNK))
    ssm_conv_w = dense((L, SSM_CONV, SSM_CONV_DIM), SSM_CONV)
    ssm_conv_b = bias((L, SSM_CONV_DIM))
    u = jax.random.uniform(next(ks), (L, SSM_HEADS), f32)
    dt0 = jnp.maximum(jnp.exp(u * (jnp.log(0.1) - jnp.log(0.001)) + jnp.log(0.001)), 1e-4)
    ssm_dt_bias = dt0 + jnp.log(-jnp.expm1(-dt0))
    ssm_a_log = jnp.log(jax.random.uniform(next(ks), (L, SSM_HEADS), f32, 1.0, 16.0))
    ssm_d = gain((L, SSM_HEADS))
    ssm_norm = gain((L, W_SSM))
    w_out = dense((L, D_MIX, D_MODEL), D_MIX)
    ffn2_norm = gain((L, D_MODEL))
    ffn2_w_gate = dense((L, D_MODEL, D_FF), D_MODEL)
    ffn2_w_up = dense((L, D_MODEL, D_FF), D_MODEL)
    ffn2_w_down = dense((L, D_FF, D_MODEL), D_FF)
    final_norm = gain((D_MODEL,))
    return {
        "x": x,
        "ffn1_norm": ffn1_norm, "ffn1_w_gate": ffn1_w_gate, "ffn1_w_up": ffn1_w_up, "ffn1_w_down": ffn1_w_down,
        "mix_norm": mix_norm, "w_in": w_in,
        "pool_w": pool_w, "pool_scale": pool_scale,
        "conv_dw_w": conv_dw_w, "conv_dw_b": conv_dw_b, "conv_ln_g": conv_ln_g, "conv_ln_b": conv_ln_b,
        "conv_pw_w": conv_pw_w, "conv_pw_b": conv_pw_b,
        "sgu_ln_g": sgu_ln_g, "sgu_ln_b": sgu_ln_b, "sgu_w_s": sgu_w_s, "sgu_b": sgu_b,
        "ssm_conv_w": ssm_conv_w, "ssm_conv_b": ssm_conv_b, "ssm_dt_bias": ssm_dt_bias,
        "ssm_a_log": ssm_a_log, "ssm_d": ssm_d, "ssm_norm": ssm_norm,
        "w_out": w_out,
        "ffn2_norm": ffn2_norm, "ffn2_w_gate": ffn2_w_gate, "ffn2_w_up": ffn2_w_up, "ffn2_w_down": ffn2_w_down,
        "final_norm": final_norm,
    }


def reference(x, ffn1_norm, ffn1_w_gate, ffn1_w_up, ffn1_w_down, mix_norm, w_in,
              pool_w, pool_scale, conv_dw_w, conv_dw_b, conv_ln_g, conv_ln_b, conv_pw_w, conv_pw_b,
              sgu_ln_g, sgu_ln_b, sgu_w_s, sgu_b, ssm_conv_w, ssm_conv_b, ssm_dt_bias, ssm_a_log,
              ssm_d, ssm_norm, w_out, ffn2_norm, ffn2_w_gate, ffn2_w_up, ffn2_w_down, final_norm):
    split_points = list(np.cumsum(IN_SIZES)[:-1])
    for l in range(DEPTH):
        h = rmsnorm(x, ffn1_norm[l])
        x = x + 0.5 * swiglu(h, ffn1_w_gate[l], ffn1_w_up[l], ffn1_w_down[l])
        h = rmsnorm(x, mix_norm[l])
        proj = h @ w_in[l]
        a, c_val, c_gate, s_u, s_v, m_z, m_xbc, m_dt = jnp.split(proj, split_points, axis=-1)
        y_a = pool_mixer(a, pool_w[l], pool_scale[l])
        y_b = conv_module(c_val, c_gate, conv_dw_w[l], conv_dw_b[l], conv_ln_g[l], conv_ln_b[l],
                          conv_pw_w[l], conv_pw_b[l])
        y_c = sgu_mixer(s_u, s_v, sgu_ln_g[l], sgu_ln_b[l], sgu_w_s[l], sgu_b[l])
        y_d = ssd_mixer(m_z, m_xbc, m_dt, ssm_conv_w[l], ssm_conv_b[l], ssm_dt_bias[l],
                        ssm_a_log[l], ssm_d[l], ssm_norm[l])
        y = jnp.concatenate([y_a, y_b.astype(y_a.dtype), y_c.astype(y_a.dtype), y_d.astype(y_a.dtype)], axis=-1)
        x = x + y @ w_out[l]
        h = rmsnorm(x, ffn2_norm[l])
        x = x + 0.5 * swiglu(h, ffn2_w_gate[l], ffn2_w_up[l], ffn2_w_down[l])
    return rmsnorm(x, final_norm)
```

```cpp
#include <hip/hip_runtime.h>
#include <cstdio>
#include <cstdint>
namespace pg8 {
#define PG8_LAS __attribute__((address_space(3)))
typedef unsigned short bf16_t;
typedef short bf16x8 __attribute__((ext_vector_type(8)));
typedef float f32x4 __attribute__((ext_vector_type(4)));
typedef unsigned u32x4 __attribute__((ext_vector_type(4)));
constexpr int BM = 256, BK = 64, HALF = 128, HTB = HALF * BK * 2  , STAGE_BYTES = 8 * HTB, NXCD = 8, WGM = 8;

__host__ __device__ __forceinline__ int lds_byte(int r, int c) { const int st = (r >> 4) * 2 + (c >> 5), rr = r & 15, cc = c & 31, ob = rr * 64 + cc * 2; return st * 1024 + (ob ^ (((ob >> 9) & 1) << 5)); }
__host__ __device__ __forceinline__ void stage_rc(int b, int& R, int& C) { const int st = b / 1024, sb = b % 1024, swz = sb ^ (((sb >> 9) & 1) << 5); R = (st >> 1) * 16 + swz / 64; C = (st & 1) * 32 + (swz % 64) / 2; }
__host__ __device__ __forceinline__ int perm32(int rho) { const int n = rho >> 4, i = rho & 15; return 8 * (i >> 2) + 4 * n + (i & 3); }

struct Unit { int pm, pn; };
struct Gemm { const bf16_t* A; const bf16_t* Bt; int M, N, K; };

struct StaticOrder {
    int nM, nN, nwg, G, c, wgm;
    __host__ __device__ void init(int M, int N, int G_, int c_, int wgm_ = WGM) { nM = M / BM; nN = N / BM; nwg = nM * nN; G = G_; c = c_; wgm = wgm_; }
    __host__ __device__ bool next(int i, Unit& u) const {
        const long L = (long)i * G + c; if (L >= nwg) return false;
        int wgid = (int)L; { const int q = nwg / NXCD, r = nwg % NXCD, xcd = wgid % NXCD, off = wgid / NXCD; wgid = (xcd < r ? xcd * (q + 1) : r * (q + 1) + (xcd - r) * q) + off; }
        const int nig = wgm * nN, gid = wgid / nig, fm = gid * wgm, gsz = (nM - fm) < wgm ? (nM - fm) : wgm;
        u.pm = fm + ((wgid % nig) % gsz); u.pn = (wgid % nig) / gsz; return true;
    }
    __device__ __forceinline__ void a_ready(const Unit&) const {}
    __device__ __forceinline__ void done(const Unit&) const {}
};
__device__ __forceinline__ unsigned cvt_pk_bf16(float lo, float hi) { unsigned r; asm volatile("v_cvt_pk_bf16_f32 %0, %1, %2" : "=v"(r) : "v"(lo), "v"(hi)); return r; }
typedef float f32x2 __attribute__((ext_vector_type(2)));
typedef __bf16 bf16x2v __attribute__((ext_vector_type(2)));
__device__ __forceinline__ unsigned pkbf(f32x2 v) { return __builtin_bit_cast(unsigned, __builtin_convertvector(v, bf16x2v)); }
struct RowScale {
    const unsigned long long* SS; const PG8_LAS float* rt; int pm0;
    __device__ __forceinline__ void load(float (&rs)[2][4], const Unit& u, int wr, int fr) const {
        if (u.pm == pm0) {
#pragma unroll
            for (int ai = 0; ai < 2; ++ai)
#pragma unroll
                for (int m = 0; m < 4; ++m) rs[ai][m] = rt[wr * 64 + fr + ai * HALF + m * 16];
        } else {
            const int row0 = u.pm * BM + wr * 64 + fr;
#pragma unroll
            for (int ai = 0; ai < 2; ++ai)
#pragma unroll
                for (int m = 0; m < 4; ++m) rs[ai][m] = __builtin_amdgcn_rsqf((float)SS[row0 + ai * HALF + m * 16] * (1.0f / (2048.0f * 1048576.0f)) + 1e-6f);
        }
    }
};
struct EpiSwiGLU {
    static constexpr bool PERM = true, AFTER_DRAIN = false;
    bf16_t* O; int ldc; RowScale R;
    __device__ __forceinline__ void operator()(const f32x4 (&acc)[2][2][4][2], const Unit& u, int wr, int wc, int fr, int fq) const {
        const int row0 = u.pm * BM + wr * 64 + fr, col0 = u.pn * HALF + wc * 32 + 8 * fq;
        float rs[2][4]; R.load(rs, u, wr, fr);
#pragma unroll
        for (int ai = 0; ai < 2; ++ai)
#pragma unroll
            for (int m = 0; m < 4; ++m) { bf16_t* rowp = O + (size_t)(row0 + ai * HALF + m * 16) * ldc + col0;
                const float r = rs[ai][m], rr = r * r, rn = r * -1.44269504089f;
                unsigned wv[4];
#pragma unroll
                for (int n = 0; n < 2; ++n)
#pragma unroll
                    for (int jp = 0; jp < 2; ++jp) { const f32x2 a = {acc[ai][0][m][n][2 * jp], acc[ai][0][m][n][2 * jp + 1]}, b = {acc[ai][1][m][n][2 * jp], acc[ai][1][m][n][2 * jp + 1]};
                        const f32x2 t = a * b, ar = a * rn;
                        f32x2 e = {__builtin_amdgcn_exp2f(ar.x), __builtin_amdgcn_exp2f(ar.y)};
                        e = e + 1.0f;
                        const f32x2 sg = {__builtin_amdgcn_rcpf(e.x), __builtin_amdgcn_rcpf(e.y)};
                        wv[2 * n + jp] = pkbf((t * rr) * sg); }
                u32x4 w; w.x = wv[0]; w.y = wv[1]; w.z = wv[2]; w.w = wv[3];
                *(u32x4*)rowp = w; }
    }
};
struct EpiBf16Rs {
    static constexpr bool PERM = true, AFTER_DRAIN = false;
    bf16_t* O; int ldc; RowScale R;
    __device__ __forceinline__ void operator()(const f32x4 (&acc)[2][2][4][2], const Unit& u, int wr, int wc, int fr, int fq) const {
        const int row0 = u.pm * BM + wr * 64 + fr, col0 = u.pn * BM + wc * 32 + 8 * fq;
        float rs[2][4]; R.load(rs, u, wr, fr);
        const int mode = (u.pn == 4 || u.pn == 5) ? 1 : (u.pn >= 6 && u.pn <= 9) ? 3 : (u.pn == 10 || u.pn == 11) ? 2 : 0;
        const float ca = mode == 3 ? 1.5957691216f : 1.0f, cb = mode == 3 ? 0.0713548163f : 0.0f;
#pragma unroll
        for (int ai = 0; ai < 2; ++ai)
#pragma unroll
            for (int m = 0; m < 4; ++m) { bf16_t* rowp = O + (size_t)(row0 + ai * HALF + m * 16) * ldc + col0; const float r = rs[ai][m];
#pragma unroll
                for (int bj = 0; bj < 2; ++bj) { unsigned wv[4];
#pragma unroll
                    for (int n = 0; n < 2; ++n)
#pragma unroll
                        for (int jp = 0; jp < 2; ++jp) { f32x2 x = {acc[ai][bj][m][n][2 * jp], acc[ai][bj][m][n][2 * jp + 1]}; x = x * r;
                            if (mode != 0) { const f32x2 y = x * ((x * x) * cb + ca) * -1.44269504089f;
                                f32x2 e = {__builtin_amdgcn_exp2f(y.x), __builtin_amdgcn_exp2f(y.y)}; e = e + 1.0f;
                                const f32x2 sg = {__builtin_amdgcn_rcpf(e.x), __builtin_amdgcn_rcpf(e.y)};
                                x = mode == 1 ? sg : x * sg; }
                            wv[2 * n + jp] = pkbf(x); }
                    u32x4 w; w.x = wv[0]; w.y = wv[1]; w.z = wv[2]; w.w = wv[3];
                    *(u32x4*)(rowp + bj * HALF) = w; } }
    }
};
struct EpiResAdd {
    static constexpr bool PERM = true, AFTER_DRAIN = false;
    bf16_t* XB; int ldc; float s; unsigned long long* SS;
    __device__ __forceinline__ void operator()(const f32x4 (&acc)[2][2][4][2], const Unit& u, int wr, int wc, int fr, int fq) const {
        const int row0 = u.pm * BM + wr * 64 + fr, col0 = u.pn * BM + wc * 32 + 8 * fq;
        u32x4 o[2][4][2];
#pragma unroll
        for (int ai = 0; ai < 2; ++ai)
#pragma unroll
            for (int m = 0; m < 4; ++m)
#pragma unroll
                for (int bj = 0; bj < 2; ++bj) o[ai][m][bj] = *(const u32x4*)(XB + (size_t)(row0 + ai * HALF + m * 16) * ldc + col0 + bj * HALF);
#pragma unroll
        for (int ai = 0; ai < 2; ++ai)
#pragma unroll
            for (int m = 0; m < 4; ++m) { bf16_t* rowp = XB + (size_t)(row0 + ai * HALF + m * 16) * ldc + col0; float sq = 0.f;
#pragma unroll
                for (int bj = 0; bj < 2; ++bj) { const u32x4 ow = o[ai][m][bj]; const f32x4 a0 = acc[ai][bj][m][0] * s, a1 = acc[ai][bj][m][1] * s;
                    u32x4 w;
                    w.x = cvt_pk_bf16(__uint_as_float(ow.x << 16) + a0[0], __uint_as_float(ow.x & 0xffff0000u) + a0[1]); w.y = cvt_pk_bf16(__uint_as_float(ow.y << 16) + a0[2], __uint_as_float(ow.y & 0xffff0000u) + a0[3]);
                    w.z = cvt_pk_bf16(__uint_as_float(ow.z << 16) + a1[0], __uint_as_float(ow.z & 0xffff0000u) + a1[1]); w.w = cvt_pk_bf16(__uint_as_float(ow.w << 16) + a1[2], __uint_as_float(ow.w & 0xffff0000u) + a1[3]);
                    *(u32x4*)(rowp + bj * HALF) = w;
                    if (SS) {
#pragma unroll
                        for (int e = 0; e < 4; ++e) { const float lo = __uint_as_float(w[e] << 16), hi = __uint_as_float(w[e] & 0xffff0000u); sq += lo * lo + hi * hi; } } }
                if (SS) { sq += __shfl_xor(sq, 16); sq += __shfl_xor(sq, 32);
                    if (fq == 0) __hip_atomic_fetch_add(SS + row0 + ai * HALF + m * 16, (unsigned long long)(sq * 1048576.0f + 0.5f), __ATOMIC_RELAXED, __HIP_MEMORY_SCOPE_AGENT); } }
    }
};

template <class Epi, class Sched, bool ALIGN_EPI = false, bool SP2 = false>
__device__ __forceinline__ void gemm_phase(PG8_LAS unsigned char* lds_in, const Gemm g, const Sched& S, const Epi& E, const int wave0) {
    PG8_LAS unsigned char* lds = lds_in; asm volatile("" : "+s"(lds));
    int wid_ = wave0; asm volatile("" : "+s"(wid_));
    unsigned msk_ = ~0u; asm volatile("" : "+s"(msk_));
    const int lane = (int)__builtin_amdgcn_mbcnt_hi(msk_, __builtin_amdgcn_mbcnt_lo(msk_, 0u)), wid = wid_, tid = wid * 64 + lane, wr = wid >> 2, wc = wid & 3, fr = lane & 15, fq = lane >> 4;
    const int K = g.K, nt = K / BK;
    unsigned voffA[2], voffB[2];
#pragma unroll
    for (int i = 0; i < 2; ++i) { int R, C; stage_rc(tid * 16 + i * 8192, R, C); const int Rb = Epi::PERM ? ((R & ~31) + perm32(R & 31)) : R;
        voffA[i] = (unsigned)(R * K + C) * 2u; voffB[i] = (unsigned)(Rb * K + C) * 2u; }
    const size_t kstep = (size_t)(BK * 2);
    const size_t hstep = (size_t)HALF * K * 2;
    const size_t tstep = 2 * hstep;
    const unsigned ldsw = (unsigned)wid * 1024u;
    const int aoff = lds_byte(wr * 64 + fr, fq * 8), boff = lds_byte(wc * 32 + fr, fq * 8);
#define PG8_SA(b, h) (((b) * 2 + (h)) * HTB)
#define PG8_SB(b, h) ((4 + (b) * 2 + (h)) * HTB)
#define PG8_STAGE(bufoff, gbase, voff) do { _Pragma("unroll") for (int _i = 0; _i < 2; ++_i) \
        __builtin_amdgcn_global_load_lds((const unsigned*)((const char*)(gbase) + (voff)[_i]), (PG8_LAS unsigned*)(lds + (bufoff) + ldsw + _i * 8192), 16, 0, 0); } while (0)
#define PG8_LDA(dst, b, h) do { _Pragma("unroll") for (int m = 0; m < 4; ++m) _Pragma("unroll") for (int k = 0; k < 2; ++k) dst[m][k] = *(const PG8_LAS bf16x8*)(lds + PG8_SA(b, h) + aoff + m * 2048 + k * 1024); } while (0)
#define PG8_LDB(dst, b, h) do { _Pragma("unroll") for (int n = 0; n < 2; ++n) _Pragma("unroll") for (int k = 0; k < 2; ++k) dst[n][k] = *(const PG8_LAS bf16x8*)(lds + PG8_SB(b, h) + boff + n * 2048 + k * 1024); } while (0)
#define PG8_MMA(ai, bj, At, Bt) do { __builtin_amdgcn_s_setprio(1); _Pragma("unroll") for (int m = 0; m < 4; ++m) _Pragma("unroll") for (int n = 0; n < 2; ++n) _Pragma("unroll") for (int k = 0; k < 2; ++k) \
        acc[ai][bj][m][n] = __builtin_amdgcn_mfma_f32_16x16x32_bf16(Bt[n][k], At[m][k], acc[ai][bj][m][n], 0, 0, 0); __builtin_amdgcn_s_setprio(0); } while (0)
#define PG8_WAIT_V(n) asm volatile("s_waitcnt vmcnt(" #n ")" ::: "memory")
#define PG8_WAIT_L(n) asm volatile("s_waitcnt lgkmcnt(" #n ")" ::: "memory")
#define PG8_BAR __builtin_amdgcn_s_barrier()
#define PG8_SCHED __builtin_amdgcn_sched_barrier(0)
    Unit cur, nxt; int ui = 0;
    if (!S.next(0, cur)) return;
    f32x4 acc[2][2][4][2];
#pragma unroll
    for (int a = 0; a < 2; ++a)
#pragma unroll
        for (int b = 0; b < 2; ++b)
#pragma unroll
            for (int m = 0; m < 4; ++m)
#pragma unroll
                for (int n = 0; n < 2; ++n) acc[a][b][m][n] = (f32x4){0.f, 0.f, 0.f, 0.f};
    bf16x8 At[4][2], B0[2][2], B1[2][2];
    const char* cA = (const char*)g.A + (size_t)cur.pm * tstep; const char* cB = (const char*)g.Bt + (size_t)cur.pn * tstep;
    S.a_ready(cur);
    if constexpr (SP2) {
        PG8_STAGE(PG8_SB(0, 0), cB, voffB); PG8_STAGE(PG8_SB(0, 1), cB + hstep, voffB); PG8_STAGE(PG8_SA(0, 0), cA, voffA); PG8_STAGE(PG8_SA(0, 1), cA + hstep, voffA);
        if (wr == 1) PG8_BAR;
        PG8_WAIT_V(2); PG8_BAR;
        PG8_STAGE(PG8_SB(1, 0), cB + kstep, voffB); PG8_STAGE(PG8_SA(1, 0), cA + kstep, voffA); PG8_STAGE(PG8_SB(1, 1), cB + hstep + kstep, voffB);
        PG8_WAIT_V(6); PG8_BAR;
    } else {
        PG8_STAGE(PG8_SB(0, 0), cB, voffB); PG8_STAGE(PG8_SA(0, 0), cA, voffA); PG8_STAGE(PG8_SB(0, 1), cB + hstep, voffB); PG8_STAGE(PG8_SA(0, 1), cA + hstep, voffA);
        if (wr == 1) PG8_BAR;
        PG8_WAIT_V(4); PG8_BAR;
        PG8_STAGE(PG8_SB(1, 0), cB + kstep, voffB); PG8_STAGE(PG8_SA(1, 0), cA + kstep, voffA); PG8_STAGE(PG8_SB(1, 1), cB + hstep + kstep, voffB);
        PG8_WAIT_V(6); PG8_BAR;
    }
    for (;;) {
        const bool has_next = S.next(ui + 1, nxt);
        const char* nA = has_next ? (const char*)g.A + (size_t)nxt.pm * tstep : cA; const char* nB = has_next ? (const char*)g.Bt + (size_t)nxt.pn * tstep : cB;
        for (int t = 0; t < nt; t += 2) {
            const bool last = (t == nt - 2);
            const char* a1 = cA + (size_t)(t + 1) * kstep;
            const char* a2 = last ? nA : cA + (size_t)(t + 2) * kstep; const char* b2 = last ? nB : cB + (size_t)(t + 2) * kstep;
            const char* a3 = a2 + kstep; const char* b3 = b2 + kstep;
            if (last && has_next) S.a_ready(nxt);
            if constexpr (SP2) {
            PG8_LDB(B0, 0, 0); PG8_LDB(B1, 0, 1); PG8_SCHED; PG8_LDA(At, 0, 0); PG8_STAGE(PG8_SA(1, 1), a1 + hstep, voffA);
            PG8_WAIT_V(8); PG8_WAIT_L(0); PG8_BAR; PG8_MMA(0, 0, At, B0); PG8_MMA(0, 1, At, B1); PG8_BAR; PG8_SCHED;
            PG8_LDA(At, 0, 1); PG8_STAGE(PG8_SB(0, 0), b2, voffB); PG8_STAGE(PG8_SB(0, 1), b2 + hstep, voffB); PG8_STAGE(PG8_SA(0, 0), a2, voffA);
            PG8_WAIT_V(8); PG8_WAIT_L(0); PG8_BAR; PG8_MMA(1, 0, At, B0); PG8_MMA(1, 1, At, B1); PG8_BAR; PG8_SCHED;
            PG8_LDB(B0, 1, 0); PG8_LDB(B1, 1, 1); PG8_SCHED; PG8_LDA(At, 1, 0); PG8_STAGE(PG8_SA(0, 1), a2 + hstep, voffA);
            PG8_WAIT_V(8); PG8_WAIT_L(0); PG8_BAR; PG8_MMA(0, 0, At, B0); PG8_MMA(0, 1, At, B1); PG8_BAR; PG8_SCHED;
            PG8_LDA(At, 1, 1); PG8_STAGE(PG8_SB(1, 0), b3, voffB); PG8_STAGE(PG8_SB(1, 1), b3 + hstep, voffB); PG8_STAGE(PG8_SA(1, 0), a3, voffA);
            PG8_WAIT_V(8); PG8_WAIT_L(0); PG8_BAR; PG8_MMA(1, 0, At, B0); PG8_MMA(1, 1, At, B1); PG8_BAR; PG8_SCHED;
            } else {
            PG8_LDB(B0, 0, 0); PG8_SCHED; PG8_LDA(At, 0, 0); PG8_STAGE(PG8_SA(1, 1), a1 + hstep, voffA);
            PG8_WAIT_L(8); PG8_BAR; PG8_WAIT_L(0); PG8_MMA(0, 0, At, B0); PG8_BAR; PG8_SCHED;
            PG8_LDB(B1, 0, 1); PG8_STAGE(PG8_SB(0, 0), b2, voffB);
            PG8_BAR; PG8_WAIT_L(0); PG8_MMA(0, 1, At, B1); PG8_BAR;
            PG8_LDA(At, 0, 1); PG8_STAGE(PG8_SA(0, 0), a2, voffA);
            PG8_BAR; PG8_WAIT_L(0); PG8_MMA(1, 0, At, B0); PG8_BAR; PG8_SCHED;
            PG8_STAGE(PG8_SB(0, 1), b2 + hstep, voffB);
            PG8_WAIT_V(6); PG8_BAR; PG8_MMA(1, 1, At, B1); PG8_BAR;
            PG8_LDB(B0, 1, 0); PG8_SCHED; PG8_LDA(At, 1, 0); PG8_STAGE(PG8_SA(0, 1), a2 + hstep, voffA);
            PG8_WAIT_L(8); PG8_BAR; PG8_WAIT_L(0); PG8_MMA(0, 0, At, B0); PG8_BAR; PG8_SCHED;
            PG8_LDB(B1, 1, 1); PG8_STAGE(PG8_SB(1, 0), b3, voffB);
            PG8_BAR; PG8_WAIT_L(0); PG8_MMA(0, 1, At, B1); PG8_BAR;
            PG8_LDA(At, 1, 1); PG8_STAGE(PG8_SA(1, 0), a3, voffA);
            PG8_BAR; PG8_WAIT_L(0); PG8_MMA(1, 0, At, B0); PG8_BAR; PG8_SCHED;
            PG8_STAGE(PG8_SB(1, 1), b3 + hstep, voffB);
            PG8_WAIT_V(6); PG8_BAR; PG8_MMA(1, 1, At, B1); PG8_BAR;
            }
        }
        if constexpr (ALIGN_EPI) { if (wr == 0) PG8_BAR; }
        if constexpr (!Epi::AFTER_DRAIN) { E(acc, cur, wr, wc, fr, fq); S.done(cur); }
        if (!has_next) break;
#pragma unroll
        for (int a = 0; a < 2; ++a)
#pragma unroll
            for (int b = 0; b < 2; ++b)
#pragma unroll
                for (int m = 0; m < 4; ++m)
#pragma unroll
                    for (int n = 0; n < 2; ++n) acc[a][b][m][n] = (f32x4){0.f, 0.f, 0.f, 0.f};
        cur = nxt; cA = nA; cB = nB; ++ui;
        if constexpr (ALIGN_EPI) { if (wr == 1) PG8_BAR; }
    }
    PG8_WAIT_V(0);
    if constexpr (!ALIGN_EPI) { if (wr == 0) PG8_BAR; }
    PG8_BAR;
    if constexpr (Epi::AFTER_DRAIN) { E.fused(acc, cur, wr, wc, fr, fq, lds, wid, lane); S.done(cur); }
#undef PG8_SA
#undef PG8_SB
#undef PG8_STAGE
#undef PG8_LDA
#undef PG8_LDB
#undef PG8_MMA
#undef PG8_WAIT_V
#undef PG8_WAIT_L
#undef PG8_BAR
#undef PG8_SCHED
}
}

constexpr int NWAVES = 8;
constexpr int BATCH = 2, SEQ = 8192, D = 2048, FF = 5632, NL = 4;
constexpr int M = BATCH * SEQ;
constexpr int INC = 4104;
constexpr int PN = 4096;
constexpr int C_A = 0, C_CVAL = 512, C_CGATE = 1024, C_SU = 1536, C_SV = 2048, C_Z = 2560, C_XBC = 3072;
constexpr int Y_A = 0, Y_B = 512, Y_C = 1024, Y_D = 1536;
constexpr float EPS = 1e-6f;
constexpr int NCH = SEQ / 128;

constexpr size_t MiB = 1u << 20;
constexpr size_t WS_CTL = 0, CTL_ZERO_BYTES = 32768;
constexpr size_t SZ_WGU = (size_t)2 * FF * D * 2, SZ_WD = (size_t)D * FF * 2, SZ_WIN = (size_t)PN * D * 2, SZ_WOUT = (size_t)D * D * 2;
constexpr size_t WS_WGU = 1 * MiB;
constexpr size_t WS_WD = WS_WGU + 2 * NL * SZ_WGU;
constexpr size_t WS_WIN = WS_WD + 2 * NL * SZ_WD;
constexpr size_t WS_WOUT = WS_WIN + NL * SZ_WIN;
constexpr size_t WS_POOLW = WS_WOUT + NL * SZ_WOUT;
constexpr size_t WS_PWT = WS_POOLW + (size_t)NL * 4 * 128 * 128 * 2;
constexpr size_t WS_WSM = WS_PWT + (size_t)NL * 512 * 512 * 2;
constexpr size_t WS_WDT = WS_WSM + (size_t)NL * 4 * 128 * 128 * 2;
constexpr size_t WS_SS = WS_WDT + (size_t)NL * 16384 * 4;
constexpr size_t WS_H = WS_SS + (size_t)3 * NL * M * 8;
constexpr size_t WS_DT = WS_H + (size_t)M * D * 2;
constexpr size_t WS_R = WS_DT + (size_t)M * 8 * 4;
constexpr size_t WS_ACT = WS_R;
constexpr size_t WS_PROJ = WS_R;
constexpr size_t WS_Y = WS_PROJ + (size_t)M * PN * 2;
constexpr size_t WS_STATES = WS_Y + (size_t)M * D * 2;
constexpr size_t WS_PREV = WS_STATES + (size_t)BATCH * NCH * 8 * 64 * 128 * 4;
constexpr size_t WS_CD = WS_PREV + (size_t)BATCH * NCH * 8 * 64 * 128 * 2;
constexpr size_t WS_XBC = WS_CD + 4096;
constexpr size_t WS_ACS = WS_XBC + (size_t)M * 1024 * 2;
constexpr size_t WS_MIXEND = WS_ACS + (size_t)256 * 1024 * 4;
constexpr size_t WS_END = WS_MIXEND > WS_ACT + (size_t)M * FF * 2 ? WS_MIXEND : WS_ACT + (size_t)M * FF * 2;
static_assert(WS_XBC % 256 == 0 && WS_ACS % 256 == 0 && WS_WGU % 256 == 0 && WS_WD % 256 == 0 && WS_WIN % 256 == 0 && WS_H % 256 == 0 && WS_R % 256 == 0 && WS_Y % 256 == 0 && WS_STATES % 256 == 0 && WS_PREV % 256 == 0, "alignment");
constexpr int CW_TMO = 0, CW_CODE = 1;
constexpr int CW_BAR = 4096;

constexpr int RING_OFF = 0, RING_BYTES = 147456;
constexpr int LDSCTL_OFF = RING_BYTES, MISC_OFF = LDSCTL_OFF + 320;
constexpr int LDS_BYTES = 151552;
static_assert(MISC_OFF + 128 <= LDS_BYTES, "LDS map");

#define GAS __attribute__((address_space(1)))
#define LAS __attribute__((address_space(3)))
typedef unsigned short bf16;
typedef unsigned v4u __attribute__((ext_vector_type(4)));
typedef unsigned v2u __attribute__((ext_vector_type(2)));
typedef float f32x4 __attribute__((ext_vector_type(4)));
typedef float f32x2 __attribute__((ext_vector_type(2)));
typedef short bf16x8 __attribute__((ext_vector_type(8)));
typedef GAS unsigned gu32;
#define RLX_AGENT __ATOMIC_RELAXED, __HIP_MEMORY_SCOPE_AGENT
#define LDS_WAIT() asm volatile("s_waitcnt lgkmcnt(0)" ::: "memory")
#define VM_WAIT() asm volatile("s_waitcnt vmcnt(0)" ::: "memory")
typedef __bf16 bf16x2_t __attribute__((ext_vector_type(2)));
__device__ __forceinline__ unsigned pk2(float lo, float hi) { const f32x2 v = {lo, hi}; const bf16x2_t b = __builtin_convertvector(v, bf16x2_t); return __builtin_bit_cast(unsigned, b); }
__device__ __forceinline__ unsigned f2bf(float f) { return pk2(f, 0.0f) & 0xffffu; }
__device__ __forceinline__ float bflo(unsigned u) { return __builtin_bit_cast(float, u << 16); }
__device__ __forceinline__ float bfhi(unsigned u) { return __builtin_bit_cast(float, u & 0xffff0000u); }
__device__ __forceinline__ float bf2f(bf16 b) { return __builtin_bit_cast(float, ((unsigned)b) << 16); }
__device__ __forceinline__ void unpack8(const v4u& w, float (&o)[8]) { o[0] = bflo(w.x); o[1] = bfhi(w.x); o[2] = bflo(w.y); o[3] = bfhi(w.y); o[4] = bflo(w.z); o[5] = bfhi(w.z); o[6] = bflo(w.w); o[7] = bfhi(w.w); }
__device__ __forceinline__ float rcp_(float x) { return __builtin_amdgcn_rcpf(x); }
__device__ __forceinline__ float rsq_(float x) { return __builtin_amdgcn_rsqf(x); }
__device__ __forceinline__ float exp_(float x) { return __builtin_amdgcn_exp2f(x * 1.44269504089f); }
__device__ __forceinline__ float sigmoidf_(float x) { return rcp_(1.0f + exp_(-x)); }
__device__ __forceinline__ float siluf_(float x) { return x * rcp_(1.0f + exp_(-x)); }
__device__ __forceinline__ float gelu_tanh(float x) { const float y2 = -2.0f * 0.7978845608028654f * (x + 0.044715f * x * x * x); return x * rcp_(1.0f + exp_(y2)); }
__device__ __forceinline__ f32x4 mfma16(bf16x8 a, bf16x8 b, f32x4 c) { return __builtin_amdgcn_mfma_f32_16x16x32_bf16(a, b, c, 0, 0, 0); }
__device__ __forceinline__ bf16x8 ldsfrag(const LAS bf16* p) { return *(const LAS bf16x8*)p; }
__device__ __forceinline__ bf16x8 glbfrag(const bf16* p) { return *(const bf16x8*)p; }
__device__ __forceinline__ unsigned imgb_off(unsigned row, unsigned ch) { return 256u * row + 16u * (ch ^ (((row & 3u) << 2) | ((row >> 2) & 3u))); }
__device__ __forceinline__ unsigned imgb_tr(unsigned lane, unsigned c, unsigned ks, unsigned t) { const unsigned g = lane >> 4, qq = (lane & 15u) >> 2, p = lane & 3u; return imgb_off(32u * ks + 8u * g + 4u * t + qq, 2u * c + (p >> 1)) + 8u * (p & 1u); }
typedef short s16x4 __attribute__((ext_vector_type(4)));
__device__ __forceinline__ bf16x8 trfrag(const LAS unsigned char* img, unsigned lane, unsigned c, unsigned ks) {
    const s16x4 lo = __builtin_amdgcn_ds_read_tr16_b64_v4i16((LAS s16x4*)(img + imgb_tr(lane, c, ks, 0u)));
    const s16x4 hi = __builtin_amdgcn_ds_read_tr16_b64_v4i16((LAS s16x4*)(img + imgb_tr(lane, c, ks, 1u)));
    return __builtin_shufflevector(lo, hi, 0, 1, 2, 3, 4, 5, 6, 7);
}

#define XB_TMO      128
#define XB_XCNT(j)  (256  + 64 * (j))
#define XB_XSUB(j)  (1280 + 64 * (j))
#define XB_XGEN(j)  (2304 + 64 * (j))
#define XB_TOP      3328
#define XB_TOPGEN   3392
#define XCD_BAR_WORDS 3456
#define XB_SPIN_CAP (1u << 18)

__device__ __forceinline__ unsigned xb_ld(unsigned* p)              { return __hip_atomic_load(p, __ATOMIC_RELAXED, __HIP_MEMORY_SCOPE_AGENT); }
__device__ __forceinline__ unsigned xb_add(unsigned* p, unsigned v) { return __hip_atomic_fetch_add(p, v, __ATOMIC_RELAXED, __HIP_MEMORY_SCOPE_AGENT); }
__device__ __forceinline__ unsigned xb_xcc_id() { return (unsigned)__builtin_amdgcn_s_getreg((3 << 11) | 20) & 0xFu; }
#define XB_SPIN(cond, bar) do { unsigned _sp = 0; while (cond) { __builtin_amdgcn_s_sleep(1); \
    if ((++_sp & 255u) == 0u) { if (xb_ld(&(bar)[XB_TMO])) break; if (_sp > XB_SPIN_CAP) { atomicAdd(&(bar)[XB_TMO], 1u); break; } } } } while (0)

struct XcdBarrier {
    unsigned* bar; unsigned x; int w0;
    volatile LAS unsigned* st;
};

__device__ __forceinline__ XcdBarrier xcd_barrier_post(unsigned* bar, volatile LAS unsigned* st) {
    XcdBarrier b; b.bar = bar; b.x = xb_xcc_id(); b.st = st; b.w0 = 0;
    if (threadIdx.x == 0) st[2] = xb_add(&bar[XB_XCNT(b.x)], 1u);
    return b;
}
__device__ __forceinline__ void xcd_barrier_complete(unsigned* bar, unsigned x, unsigned& nloc, unsigned& nx) {
    const unsigned G = gridDim.x * gridDim.y * gridDim.z;
    unsigned sum, cnt, mine, sp = 0u;
    for (;;) {
        sum = 0u; cnt = 0u; mine = 0u;
#pragma unroll
        for (unsigned j = 0; j < 16; ++j) { const unsigned c = xb_ld(&bar[XB_XCNT(j)]); sum += c; cnt += (c > 0u) ? 1u : 0u; mine = (j == x) ? c : mine; }
        if (sum == G) break;
        __builtin_amdgcn_s_sleep(1);
        if ((++sp & 255u) == 0u) { if (xb_ld(&bar[XB_TMO])) break; if (sp > XB_SPIN_CAP) { atomicAdd(&bar[XB_TMO], 1u); break; } }
    }
    nloc = mine > 0u ? mine : 1u; nx = cnt > 0u ? cnt : 1u;
}

__device__ __forceinline__ void xcd_barrier(const XcdBarrier& b) {
    asm volatile("s_waitcnt vmcnt(0)" ::: "memory");
    __syncthreads();
    unsigned xm_ = ~0u; asm volatile("" : "+s"(xm_));
    int xw_ = b.w0; asm volatile("" : "+s"(xw_));
    if (xw_ == 0 && __builtin_amdgcn_mbcnt_hi(xm_, __builtin_amdgcn_mbcnt_lo(xm_, 0u)) == 0u) {
        unsigned* bar = b.bar;
        __builtin_amdgcn_s_waitcnt(0);
        unsigned nloc = b.st[0], nx = b.st[1];
        if (nloc == 0u) { xcd_barrier_complete(bar, b.x, nloc, nx); b.st[0] = nloc; b.st[1] = nx; }
        const unsigned old = xb_add(&bar[XB_XSUB(b.x)], 1u);
        const unsigned gen = old / nloc;
        if (old + 1u == (gen + 1u) * nloc) {
            __builtin_amdgcn_fence(__ATOMIC_RELEASE, "agent");
            asm volatile("s_waitcnt vmcnt(0)" ::: "memory");
            const unsigned og = xb_add(&bar[XB_TOP], 1u);
            const unsigned tg = og / nx;
            if (og + 1u == (tg + 1u) * nx) xb_add(&bar[XB_TOPGEN], 1u);
            else XB_SPIN(xb_ld(&bar[XB_TOPGEN]) == tg, bar);
            __builtin_amdgcn_fence(__ATOMIC_ACQUIRE, "agent");
            xb_add(&bar[XB_XGEN(b.x)], 1u);
            asm volatile("s_waitcnt vmcnt(0)" ::: "memory");
        } else {
            XB_SPIN(xb_ld(&bar[XB_XGEN(b.x)]) == gen, bar);
            __builtin_amdgcn_fence(__ATOMIC_ACQUIRE, "agent");
            asm volatile("s_waitcnt vmcnt(0)" ::: "memory");
        }
    }
    __syncthreads();
}


struct Frame {
    LAS unsigned char* lds;
    volatile LAS unsigned* MISC;
    gu32* ctl;
    int G, wave0, vb;
};
struct Ids { int tid, lane, wave; };
__device__ __forceinline__ LAS unsigned char* fresh_lds(LAS unsigned char* p) { asm volatile("" : "+s"(p)); return p; }
__device__ __forceinline__ int fresh_lane() { unsigned m = ~0u; asm volatile("" : "+s"(m)); return (int)__builtin_amdgcn_mbcnt_hi(m, __builtin_amdgcn_mbcnt_lo(m, 0u)); }
__device__ __forceinline__ Ids fresh_ids(const Frame& F) { Ids r; r.lane = fresh_lane(); int w_ = F.wave0; asm volatile("" : "+s"(w_)); r.wave = w_; r.tid = r.wave * 64 + r.lane; return r; }
__device__ __forceinline__ void wave_sum4(float (&v)[4]) {
#pragma unroll
    for (int o = 1; o < 64; o <<= 1) { float t[4];
#pragma unroll
        for (int i = 0; i < 4; ++i) t[i] = __shfl_xor(v[i], o);
#pragma unroll
        for (int i = 0; i < 4; ++i) v[i] += t[i]; }
}
__device__ __forceinline__ float wave_sum(float v) {
#pragma unroll
    for (int o = 1; o < 64; o <<= 1) v += __shfl_xor(v, o);
    return v;
}

__device__ __forceinline__ void transpose_item(const float* W, int ldw, int KD, bf16* WT, int drow0, int k0, int n0, LAS float* scr, int lane, const float* kscale) {
    const int c = lane & 7;
    f32x4 g0 = {1.f, 1.f, 1.f, 1.f}, g1 = {1.f, 1.f, 1.f, 1.f};
    if (kscale) { g0 = *(const f32x4*)(kscale + k0 + 8 * c); g1 = *(const f32x4*)(kscale + k0 + 8 * c + 4); }
#pragma unroll 8
    for (int i = 0; i < 32; ++i) { const int kk = 2 * i + (lane >> 5); scr[kk * 33 + (lane & 31)] = W[(size_t)(k0 + kk) * ldw + n0 + (lane & 31)]; }
    LDS_WAIT(); asm volatile("" ::: "memory");
#pragma unroll
    for (int j = 0; j < 4; ++j) { const int n = (lane >> 3) + 8 * j; const LAS float* s = scr + (8 * c) * 33 + n;
        v4u o; o.x = pk2(s[0 * 33] * g0.x, s[1 * 33] * g0.y); o.y = pk2(s[2 * 33] * g0.z, s[3 * 33] * g0.w); o.z = pk2(s[4 * 33] * g1.x, s[5 * 33] * g1.y); o.w = pk2(s[6 * 33] * g1.z, s[7 * 33] * g1.w);
        *(GAS v4u*)(WT + (size_t)(drow0 + n) * KD + k0 + 8 * c) = o; }
    LDS_WAIT(); asm volatile("" ::: "memory");
}
struct Ptrs {
    const float *x, *ffn_norm[2], *ffn_wg[2], *ffn_wu[2], *ffn_wd[2], *mix_norm, *w_in, *pool_w, *pool_scale, *cdw_w, *cdw_b, *cln_g, *cln_b, *cpw_w, *cpw_b,
        *sln_g, *sln_b, *sgu_ws, *sgu_b, *ssm_cw, *ssm_cb, *ssm_dtb, *ssm_alog, *ssm_d, *ssm_norm, *w_out, *final_norm;
    float* X;
    bf16 *Wgu, *Wd, *Win, *Wout, *PoolW, *PwT, *WsM, *H, *ACT, *PROJ, *Y, *PREV;
    float *DT, *STATES, *CD, *ACS, *WDT;
    unsigned long long* SS;
    bf16* XBC;
};
constexpr int PTR_OFF = MISC_OFF + 128;
static_assert(PTR_OFF + 33 * 8 <= LDS_BYTES, "LDS map");
__device__ __forceinline__ unsigned long long ldq(const LAS unsigned char* tbl, int i) { const LAS unsigned* t = (const LAS unsigned*)(tbl + PTR_OFF) + 2 * i;
    return ((unsigned long long)(unsigned)__builtin_amdgcn_readfirstlane((int)t[1]) << 32) | (unsigned long long)(unsigned)__builtin_amdgcn_readfirstlane((int)t[0]); }
__device__ __forceinline__ const float* inp(const LAS unsigned char* F, int i) { return (const float*)(const GAS float*)ldq(F, i); }
__device__ __forceinline__ int fresh_vb(const Frame& F) { int b = F.vb; asm volatile("" : "+s"(b)); return b; }
__device__ __forceinline__ int fresh_bid() { int b = blockIdx.x; asm volatile("" : "+s"(b)); return b; }
__device__ __forceinline__ Ptrs load_ptrs(const Frame& Fr) {
    const LAS unsigned char* F = Fr.lds; asm volatile("" : "+s"(F));
    Ptrs P;
    P.x = inp(F, 0);
    P.ffn_norm[0] = inp(F, 1); P.ffn_wg[0] = inp(F, 2); P.ffn_wu[0] = inp(F, 3); P.ffn_wd[0] = inp(F, 4);
    P.mix_norm = inp(F, 5); P.w_in = inp(F, 6); P.pool_w = inp(F, 7); P.pool_scale = inp(F, 8);
    P.cdw_w = inp(F, 9); P.cdw_b = inp(F, 10); P.cln_g = inp(F, 11); P.cln_b = inp(F, 12); P.cpw_w = inp(F, 13); P.cpw_b = inp(F, 14);
    P.sln_g = inp(F, 15); P.sln_b = inp(F, 16); P.sgu_ws = inp(F, 17); P.sgu_b = inp(F, 18);
    P.ssm_cw = inp(F, 19); P.ssm_cb = inp(F, 20); P.ssm_dtb = inp(F, 21); P.ssm_alog = inp(F, 22); P.ssm_d = inp(F, 23); P.ssm_norm = inp(F, 24);
    P.w_out = inp(F, 25);
    P.ffn_norm[1] = inp(F, 26); P.ffn_wg[1] = inp(F, 27); P.ffn_wu[1] = inp(F, 28); P.ffn_wd[1] = inp(F, 29);
    P.final_norm = inp(F, 30);
    P.X = (float*)(GAS float*)ldq(F, 31);
    unsigned char* ws = (unsigned char*)(GAS unsigned char*)ldq(F, 32);
    P.Wgu = (bf16*)(ws + WS_WGU); P.Wd = (bf16*)(ws + WS_WD); P.Win = (bf16*)(ws + WS_WIN); P.Wout = (bf16*)(ws + WS_WOUT);
    P.PoolW = (bf16*)(ws + WS_POOLW); P.PwT = (bf16*)(ws + WS_PWT); P.WsM = (bf16*)(ws + WS_WSM);
    P.H = (bf16*)(ws + WS_H); P.ACT = (bf16*)(ws + WS_ACT); P.PROJ = (bf16*)(ws + WS_PROJ); P.Y = (bf16*)(ws + WS_Y); P.PREV = (bf16*)(ws + WS_PREV);
    P.DT = (float*)(ws + WS_DT); P.STATES = (float*)(ws + WS_STATES); P.CD = (float*)(ws + WS_CD); P.ACS = (float*)(ws + WS_ACS); P.WDT = (float*)(ws + WS_WDT); P.SS = (unsigned long long*)(ws + WS_SS); P.XBC = (bf16*)(ws + WS_XBC);
    return P;
}
constexpr int IT_FFN = (D / 64) * (FF / 32);
constexpr int IT_WIN = (D / 64) * (PN / 32), IT_WOUT = (D / 64) * (D / 32);
constexpr int IT_PW = (512 / 64) * (512 / 32);
constexpr int IT_LAYER = 6 * IT_FFN + IT_WIN + IT_WOUT + IT_PW, IT_ALL = NL * IT_LAYER;
#define TI_DECODE(it_, W_, WT_, KS_, ldw_, KD_, dr_, k0_, n0_) do { \
        const int l_ = (it_) / IT_LAYER; int r_ = (it_) % IT_LAYER; \
        if (r_ < 6 * IT_FFN) { \
            const int f_ = r_ / (3 * IT_FFN); r_ -= f_ * 3 * IT_FFN; const int which_ = r_ / IT_FFN; r_ -= which_ * IT_FFN; \
            if (which_ < 2) {     \
                const int nblk_ = FF / 32, kb_ = r_ / nblk_, nb_ = r_ % nblk_, nn_ = 32 * nb_; \
                W_ = (which_ == 0 ? (f_ ? P.ffn_wg[1] : P.ffn_wg[0]) : (f_ ? P.ffn_wu[1] : P.ffn_wu[0])) + (size_t)l_ * D * FF; \
                WT_ = P.Wgu + (size_t)(l_ * 2 + f_) * (2 * FF) * D; KS_ = (f_ ? P.ffn_norm[1] : P.ffn_norm[0]) + (size_t)l_ * D; \
                ldw_ = FF; KD_ = D; dr_ = (nn_ >> 7) * 256 + (which_ ? 128 : 0) + (nn_ & 127); k0_ = 64 * kb_; n0_ = nn_; \
            } else {              \
                const int nblk_ = D / 32, kb_ = r_ / nblk_, nb_ = r_ % nblk_; \
                W_ = (f_ ? P.ffn_wd[1] : P.ffn_wd[0]) + (size_t)l_ * FF * D; WT_ = P.Wd + (size_t)(l_ * 2 + f_) * D * FF; KS_ = nullptr; \
                ldw_ = D; KD_ = FF; dr_ = 32 * nb_; k0_ = 64 * kb_; n0_ = 32 * nb_; } \
        } else { r_ -= 6 * IT_FFN; \
            if (r_ < IT_WIN) { const int nblk_ = PN / 32, kb_ = r_ / nblk_, nb_ = r_ % nblk_;     \
                W_ = P.w_in + (size_t)l_ * D * INC; WT_ = P.Win + (size_t)l_ * PN * D; KS_ = P.mix_norm + (size_t)l_ * D; ldw_ = INC; KD_ = D; dr_ = 32 * nb_; k0_ = 64 * kb_; n0_ = 32 * nb_; \
            } else if (r_ < IT_WIN + IT_WOUT) { r_ -= IT_WIN; const int nblk_ = D / 32, kb_ = r_ / nblk_, nb_ = r_ % nblk_; \
                W_ = P.w_out + (size_t)l_ * D * D; WT_ = P.Wout + (size_t)l_ * D * D; KS_ = nullptr; ldw_ = D; KD_ = D; dr_ = 32 * nb_; k0_ = 64 * kb_; n0_ = 32 * nb_; \
            } else { r_ -= IT_WIN + IT_WOUT; const int nblk_ = 512 / 32, kb_ = r_ / nblk_, nb_ = r_ % nblk_;         \
                W_ = P.cpw_w + (size_t)l_ * 512 * 512; WT_ = P.PwT + (size_t)l_ * 512 * 512; KS_ = nullptr; ldw_ = 512; KD_ = 512; dr_ = 32 * nb_; k0_ = 64 * kb_; n0_ = 32 * nb_; } } } while (0)
#define TI_LOAD(v_, g0_, g1_, W_, KS_, ldw_, k0_, n0_) do { const float* wp_ = W_ + (size_t)(k0_ + (I.lane >> 3)) * ldw_ + n0_ + 4 * (I.lane & 7); \
        _Pragma("unroll") for (int i_ = 0; i_ < 8; ++i_) v_[i_] = *(const f32x4*)(wp_ + (size_t)(8 * i_) * ldw_); \
        g0_ = (f32x4){1.f, 1.f, 1.f, 1.f}; g1_ = g0_; if (KS_) { g0_ = *(const f32x4*)(KS_ + k0_ + 8 * (I.lane & 7)); g1_ = *(const f32x4*)(KS_ + k0_ + 8 * (I.lane & 7) + 4); } } while (0)
__device__ __forceinline__ void convert_range(Frame& F, const int ib, const int ie, const int gw, const int NGW) {
    __syncthreads();
    const Ptrs P = load_ptrs(F); const Ids I = fresh_ids(F);
    LAS unsigned char* const L = fresh_lds(F.lds);
    LAS float* scr = (LAS float*)(L + RING_OFF + I.wave * 16384);
    const float* tW = nullptr; const float* tKS = nullptr; int tldw = 0, tn0 = 0;
    bf16* cWT = nullptr; int cKD = 0, cdr = 0, ck0 = 0; f32x4 v[8]; f32x4 g0 = {1.f, 1.f, 1.f, 1.f}, g1 = g0;
    bf16* aWT = nullptr; int aKD = 0, adr = 0, ak0 = 0; f32x4 va[8]; f32x4 ga0 = g0, ga1 = g0;
#pragma unroll
    for (int i = 0; i < 8; ++i) { v[i] = (f32x4){0.f, 0.f, 0.f, 0.f}; va[i] = v[i]; }
    int it = ib + gw;
    if (it < ie) { TI_DECODE(it, tW, cWT, tKS, tldw, cKD, cdr, ck0, tn0); TI_LOAD(v, g0, g1, tW, tKS, tldw, ck0, tn0); }
    if (it + NGW < ie) { TI_DECODE(it + NGW, tW, aWT, tKS, tldw, aKD, adr, ak0, tn0); TI_LOAD(va, ga0, ga1, tW, tKS, tldw, ak0, tn0); }
#pragma unroll 1
    while (it < ie) {
        const int nx2 = it + 2 * NGW;
        bf16* bWT = nullptr; int bKD = 0, bdr = 0, bk0 = 0; f32x4 vb[8]; f32x4 gb0 = {1.f, 1.f, 1.f, 1.f}, gb1 = gb0;
#pragma unroll
        for (int i = 0; i < 8; ++i) vb[i] = (f32x4){0.f, 0.f, 0.f, 0.f};
        if (nx2 < ie) { TI_DECODE(nx2, tW, bWT, tKS, tldw, bKD, bdr, bk0, tn0); TI_LOAD(vb, gb0, gb1, tW, tKS, tldw, bk0, tn0); }
#pragma unroll
        for (int i = 0; i < 8; ++i) { LAS float* wq = scr + (8 * i + (I.lane >> 3)) * 33 + 4 * (I.lane & 7); wq[0] = v[i].x; wq[1] = v[i].y; wq[2] = v[i].z; wq[3] = v[i].w; }
        LDS_WAIT(); asm volatile("" ::: "memory");
        { const int c = I.lane & 7;
#pragma unroll
          for (int j = 0; j < 4; ++j) { const int n = (I.lane >> 3) + 8 * j; const LAS float* sp = scr + (8 * c) * 33 + n;
              v4u o; o.x = pk2(sp[0 * 33] * g0.x, sp[1 * 33] * g0.y); o.y = pk2(sp[2 * 33] * g0.z, sp[3 * 33] * g0.w); o.z = pk2(sp[4 * 33] * g1.x, sp[5 * 33] * g1.y); o.w = pk2(sp[6 * 33] * g1.z, sp[7 * 33] * g1.w);
              *(GAS v4u*)(cWT + (size_t)(cdr + n) * cKD + ck0 + 8 * c) = o; } }
        LDS_WAIT(); asm volatile("" ::: "memory");
#pragma unroll
        for (int i = 0; i < 8; ++i) { v[i] = va[i]; va[i] = vb[i]; }
        g0 = ga0; g1 = ga1; cWT = aWT; cKD = aKD; cdr = adr; ck0 = ak0;
        ga0 = gb0; ga1 = gb1; aWT = bWT; aKD = bKD; adr = bdr; ak0 = bk0; it += NGW;
    }
    __syncthreads();
}
__device__ __forceinline__ void prologue_small(Frame& F) {
    const Ptrs P = load_ptrs(F); const Ids I = fresh_ids(F);
    const int gt = fresh_bid() * (NWAVES * 64) + I.tid, NGT = F.G * NWAVES * 64;
    for (int i = gt; i < NL * 4 * 128 * 128; i += NGT) {
        const int c = i & 127, d = (i >> 7) & 127, lg = i >> 14;
        P.PoolW[i] = (bf16)f2bf(P.pool_w[((size_t)lg * 128 + c) * 128 + d] * P.pool_scale[(size_t)lg * 128 + d]);
        P.WsM[i] = (bf16)f2bf(c <= d ? P.sgu_ws[i] : 0.0f);
    }
    for (int i = gt; i < (3 * NL - 1) * M; i += NGT) P.SS[M + i] = 0ull;
    for (int i = gt; i < NL * 16384; i += NGT) {
        const int l = i >> 14, rem = i & 16383, k = rem >> 3, j8 = rem & 7, ln = (k >> 2) & 63, j = k >> 8, ii = k & 3, slot = (j * 4 + ii) * 64 + ln;
        P.WDT[(size_t)l * 16384 + (j8 >> 2) * 8192 + slot * 4 + (j8 & 3)] = P.mix_norm[(size_t)l * D + k] * P.w_in[((size_t)l * D + k) * INC + PN + j8];
    }
}

constexpr int RP_FIRST = 0, RP_DT = 1, RP_FINAL = 2;
template <int MODE>
__device__ __forceinline__ void row_phase(Frame& F, const float* xin, bf16* XB, unsigned long long* SS0, const float* gain, float* outf, const float* wdt  , float* DT) {
    const Ids I = fresh_ids(F);
    const int gw = fresh_bid() * NWAVES + I.wave, NGW = F.G * NWAVES;
    LAS unsigned char* const L = fresh_lds(F.lds);
    LAS float* wlA = (LAS float*)(L + RING_OFF);
    LAS float* wlB = (LAS float*)(L + RING_OFF + 32768);
    if (MODE == RP_DT) {
        __syncthreads();
        v4u tb[8];
#pragma unroll
        for (int i = 0; i < 8; ++i) tb[i] = *(const v4u*)(wdt + (size_t)(I.tid + 512 * i) * 4);
#pragma unroll
        for (int i = 0; i < 8; ++i) *(LAS v4u*)(wlA + (I.tid + 512 * i) * 4) = tb[i];
        __syncthreads();
    }
    f32x4 g[8];
    if (MODE == RP_FINAL) {
#pragma unroll
        for (int j = 0; j < 8; ++j) g[j] = ((const f32x4*)gain)[I.lane + 64 * j]; }
    if (MODE == RP_FIRST) {
        f32x4 nx[8];
        if (gw < M) { const f32x4* xr = (const f32x4*)(xin + (size_t)gw * D) + I.lane;
#pragma unroll
            for (int j = 0; j < 8; ++j) nx[j] = xr[64 * j]; }
#pragma unroll 1
        for (int m = gw; m < M; m += NGW) {
            f32x4 v[8];
#pragma unroll
            for (int j = 0; j < 8; ++j) v[j] = nx[j];
            if (m + NGW < M) { const f32x4* xr = (const f32x4*)(xin + (size_t)(m + NGW) * D) + I.lane;
#pragma unroll
                for (int j = 0; j < 8; ++j) nx[j] = xr[64 * j]; }
            float ss = 0.f; v2u* o8 = (v2u*)(XB + (size_t)m * D) + I.lane;
#pragma unroll
            for (int j = 0; j < 8; ++j) { v2u w; w.x = pk2(v[j].x, v[j].y); w.y = pk2(v[j].z, v[j].w); o8[64 * j] = w;
                const float a = bflo(w.x), b = bfhi(w.x), c = bflo(w.y), d = bfhi(w.y); ss += (a * a + b * b) + (c * c + d * d); }
            ss = wave_sum(ss);
            if (I.lane == 0) SS0[m] = (unsigned long long)(ss * 1048576.0f + 0.5f);
        }
    } else {
        v2u nx[8];
        if (gw < M) { const v2u* xr = (const v2u*)(XB + (size_t)gw * D) + I.lane;
#pragma unroll
            for (int j = 0; j < 8; ++j) nx[j] = xr[64 * j]; }
#pragma unroll 1
        for (int m = gw; m < M; m += NGW) {
            f32x4 v[8]; float ss = 0.f;
#pragma unroll
            for (int j = 0; j < 8; ++j) { v[j] = (f32x4){bflo(nx[j].x), bfhi(nx[j].x), bflo(nx[j].y), bfhi(nx[j].y)}; ss += (v[j].x * v[j].x + v[j].y * v[j].y) + (v[j].z * v[j].z + v[j].w * v[j].w); }
            if (m + NGW < M) { const v2u* xr = (const v2u*)(XB + (size_t)(m + NGW) * D) + I.lane;
#pragma unroll
                for (int j = 0; j < 8; ++j) nx[j] = xr[64 * j]; }
            const float rstd = 1.0f / sqrtf(wave_sum(ss) * (1.0f / D) + EPS);
            if (MODE == RP_DT) {
                f32x4 a0 = {0.f, 0.f, 0.f, 0.f}, a1 = {0.f, 0.f, 0.f, 0.f};
#pragma unroll
                for (int j = 0; j < 8; ++j) { asm volatile("" ::: "memory");
#pragma unroll
                    for (int i = 0; i < 4; ++i) { const int slot = (j * 4 + i) * 64 + I.lane; const f32x4 w0 = *(const LAS f32x4*)(wlA + slot * 4), w1 = *(const LAS f32x4*)(wlB + slot * 4); const float xv = v[j][i]; a0 += w0 * xv; a1 += w1 * xv; } }
                float r8[8] = {a0.x, a0.y, a0.z, a0.w, a1.x, a1.y, a1.z, a1.w};
#pragma unroll
                for (int e = 0; e < 8; ++e) r8[e] = wave_sum(r8[e]) * rstd;
                if (I.lane == 0) { f32x4* dp = (f32x4*)(DT + (size_t)m * 8); dp[0] = (f32x4){r8[0], r8[1], r8[2], r8[3]}; dp[1] = (f32x4){r8[4], r8[5], r8[6], r8[7]}; }
            } else { f32x4* o = (f32x4*)(outf + (size_t)m * D) + I.lane;
#pragma unroll
                for (int j = 0; j < 8; ++j) o[64 * j] = v[j] * rstd * g[j]; }
        }
    }
}

__device__ __forceinline__ int pc32(int b, int i) { return 32 * (i >> 2) + 4 * b + (i & 3); }
__device__ __forceinline__ int pc16(int b, int i) { return 16 * (i >> 2) + 4 * b + (i & 3); }
__device__ __forceinline__ void pool_unit(Frame& F, int l, int u) {
    __syncthreads();
    const Ptrs P = load_ptrs(F); const Ids I = fresh_ids(F); LAS unsigned char* const L = fresh_lds(F.lds);
    LAS bf16* RAW = (LAS bf16*)(L + RING_OFF);
    LAS bf16* Pl = (LAS bf16*)(L + RING_OFF + 80896);
    static_assert(80896 + 64 * 520 * 2 <= RING_BYTES, "pool LDS map");
    const int m0 = u * 64, pos0 = m0 & (SEQ - 1);
    const int r = I.lane & 15, q = I.lane >> 4, gq = I.wave >> 1, ch = (I.wave & 1) * 64;
    {
        v4u rw[10];
#pragma unroll
        for (int i = 0; i < 10; ++i) { const int it = I.tid + 512 * i, jr = it >> 6, cg = it & 63; rw[i] = (v4u){0u, 0u, 0u, 0u};
            if (it < 79 * 64 && pos0 + jr - 15 >= 0) rw[i] = *(const v4u*)(P.PROJ + (size_t)(m0 + jr - 15) * PN + C_A + cg * 8); }
#pragma unroll
        for (int i = 0; i < 10; ++i) { const int it = I.tid + 512 * i; if (it < 79 * 64) *(LAS v4u*)(RAW + (it >> 6) * 512 + (it & 63) * 8) = rw[i]; }
    }
    bf16x8 wf[4][4];
    { const bf16* Wt = P.PoolW + (size_t)(l * 4 + gq) * 128 * 128 + q * 8;
#pragma unroll
      for (int ks = 0; ks < 4; ++ks)
#pragma unroll
          for (int b = 0; b < 4; ++b) wf[ks][b] = glbfrag(Wt + (size_t)(ch + pc16(b, r)) * 128 + ks * 32); }
    __syncthreads();
    { const int win = 2 << gq, th = I.wave & 1;
#pragma unroll 1
      for (int i = 0; i < 8; ++i) { const int it = I.lane + 64 * i, t = 32 * th + (it >> 4), c = it & 15, pos = pos0 + t;
          const LAS bf16* rp = RAW + (t + 15) * 512 + gq * 128 + c * 8;
          float cur[8], sum[8]; { const v4u w = *(const LAS v4u*)rp; unpack8(w, cur); }
#pragma unroll
          for (int e = 0; e < 8; ++e) sum[e] = cur[e];
#pragma unroll 1
          for (int k = 1; k < win; ++k) { const v4u w = *(const LAS v4u*)(rp - k * 512); float x[8]; unpack8(w, x);
#pragma unroll
              for (int e = 0; e < 8; ++e) sum[e] += x[e]; }
          const float inv = rcp_((float)(pos + 1 < win ? pos + 1 : win));
          v4u o; o.x = pk2(sum[0] * inv - cur[0], sum[1] * inv - cur[1]); o.y = pk2(sum[2] * inv - cur[2], sum[3] * inv - cur[3]);
          o.z = pk2(sum[4] * inv - cur[4], sum[5] * inv - cur[5]); o.w = pk2(sum[6] * inv - cur[6], sum[7] * inv - cur[7]);
          *(LAS v4u*)(Pl + t * 520 + gq * 128 + c * 8) = o; } }
    __syncthreads();
#pragma unroll 1
    for (int a = 0; a < 4; ++a) {
        f32x4 acc[4];
#pragma unroll
        for (int b = 0; b < 4; ++b) acc[b] = (f32x4){0.f, 0.f, 0.f, 0.f};
#pragma unroll
        for (int ks = 0; ks < 4; ++ks) { const bf16x8 af = ldsfrag(Pl + (a * 16 + r) * 520 + gq * 128 + ks * 32 + q * 8);
#pragma unroll
            for (int b = 0; b < 4; ++b) acc[b] = mfma16(wf[ks][b], af, acc[b]); }
        bf16* yp = P.Y + (size_t)(m0 + a * 16 + r) * D + Y_A + gq * 128 + ch + 16 * q;
        v4u o0, o1; o0.x = pk2(acc[0].x, acc[0].y); o0.y = pk2(acc[0].z, acc[0].w); o0.z = pk2(acc[1].x, acc[1].y); o0.w = pk2(acc[1].z, acc[1].w);
        o1.x = pk2(acc[2].x, acc[2].y); o1.y = pk2(acc[2].z, acc[2].w); o1.z = pk2(acc[3].x, acc[3].y); o1.w = pk2(acc[3].z, acc[3].w);
        *(v4u*)yp = o0; *(v4u*)(yp + 8) = o1; }
}

template <int COPY> __device__ __forceinline__ void conv_unit(Frame& F, int l, int u) {
    __syncthreads();
    const Ptrs P = load_ptrs(F); const Ids I = fresh_ids(F); LAS unsigned char* const L = fresh_lds(F.lds);
    LAS bf16* GL = (LAS bf16*)(L + RING_OFF);
    LAS float* CO = (LAS float*)(L + RING_OFF + 65536);
    const int m0 = u * 32, pos0 = m0 & (SEQ - 1);
    const int cp = I.tid & 255, th = I.tid >> 8;
    f32x2 w[31];
#pragma unroll
    for (int k = 0; k < 31; ++k) w[k] = *(const f32x2*)(P.cdw_w + ((size_t)l * 31 + k) * 512 + 2 * cp);
    const f32x2 b2 = *(const f32x2*)(P.cdw_b + (size_t)l * 512 + 2 * cp);
    {
        v4u vv[8], gg[8];
#pragma unroll
        for (int i = 0; i < 8; ++i) { const int it = I.tid + 512 * i, jr = it >> 6, cg = it & 63;
            vv[i] = (v4u){0u, 0u, 0u, 0u}; gg[i] = (v4u){0u, 0u, 0u, 0u};
            if (it < 62 * 64 && pos0 + jr - 30 >= 0) { const bf16* rowp = P.PROJ + (size_t)(m0 + jr - 30) * PN + cg * 8; vv[i] = *(const v4u*)(rowp + C_CVAL); gg[i] = *(const v4u*)(rowp + C_CGATE); } }
#pragma unroll
        for (int i = 0; i < 8; ++i) { const int it = I.tid + 512 * i, jr = it >> 6, cg = it & 63;
            if (it < 62 * 64) { float a[8], b[8]; unpack8(vv[i], a); unpack8(gg[i], b);
                v4u o; o.x = pk2(a[0] * b[0], a[1] * b[1]); o.y = pk2(a[2] * b[2], a[3] * b[3]);
                o.z = pk2(a[4] * b[4], a[5] * b[5]); o.w = pk2(a[6] * b[6], a[7] * b[7]);
                *(LAS v4u*)(GL + jr * 512 + cg * 8) = o; } }
    }
    __syncthreads();
    {
#pragma unroll 1
        for (int g8 = 0; g8 < 2; ++g8) { const int t0 = 16 * th + 8 * g8;
            f32x2 acc[8] = {b2, b2, b2, b2, b2, b2, b2, b2};
            const LAS bf16* gp = GL + t0 * 512 + 2 * cp;
            unsigned gw[38];
#pragma unroll
            for (int j = 0; j < 38; ++j) gw[j] = *(const LAS unsigned*)(gp + j * 512);
#pragma unroll
            for (int j = 0; j < 38; ++j) { const f32x2 gv = {bflo(gw[j]), bfhi(gw[j])};
#pragma unroll
                for (int t = 0; t < 8; ++t) { const int k = j - t; if (k >= 0 && k <= 30) acc[t] += w[k] * gv; } }
#pragma unroll
            for (int t = 0; t < 8; ++t) *(LAS f32x2*)(CO + (t0 + t) * 516 + 2 * cp) = acc[t]; }
    }
    const int r = I.lane & 15, q = I.lane >> 4, n0 = I.wave * 64;
    const bf16* Wt = P.PwT + (size_t)l * 512 * 512 + q * 8;
    bf16x8 wA[4][4], wB[4][4];
#define CV_LOAD(dst, s) do { _Pragma("unroll") for (int ks = 0; ks < 4; ++ks) _Pragma("unroll") for (int b = 0; b < 4; ++b) dst[ks][b] = glbfrag(Wt + (size_t)(n0 + pc16(b, r)) * 512 + ((s) * 4 + ks) * 32); } while (0)
    const f32x4 lg0 = *(const f32x4*)(P.cln_g + (size_t)l * 512 + I.lane * 4), lg1 = *(const f32x4*)(P.cln_g + (size_t)l * 512 + 256 + I.lane * 4);
    const f32x4 lb0 = *(const f32x4*)(P.cln_b + (size_t)l * 512 + I.lane * 4), lb1 = *(const f32x4*)(P.cln_b + (size_t)l * 512 + 256 + I.lane * 4);
    CV_LOAD(wA, 0); CV_LOAD(wB, 1);
    const float* pbp = P.cpw_b + (size_t)l * 512 + n0 + 16 * q;
    const f32x4 pb0 = *(const f32x4*)pbp, pb1 = *(const f32x4*)(pbp + 4), pb2 = *(const f32x4*)(pbp + 8), pb3 = *(const f32x4*)(pbp + 12);
    __syncthreads();
    {
        f32x4 x0[4], x1[4]; float sm[4];
#pragma unroll
        for (int i = 0; i < 4; ++i) { const int t = I.wave * 4 + i;
            x0[i] = *(const LAS f32x4*)(CO + t * 516 + I.lane * 4); x1[i] = *(const LAS f32x4*)(CO + t * 516 + 256 + I.lane * 4);
            sm[i] = (x0[i].x + x0[i].y) + (x0[i].z + x0[i].w) + (x1[i].x + x1[i].y) + (x1[i].z + x1[i].w); }
        wave_sum4(sm);
#pragma unroll
        for (int i = 0; i < 4; ++i) { const float mean = sm[i] * (1.0f / 512.0f);
            x0[i] = x0[i] - mean; x1[i] = x1[i] - mean;
            sm[i] = (x0[i].x * x0[i].x + x0[i].y * x0[i].y) + (x0[i].z * x0[i].z + x0[i].w * x0[i].w) + (x1[i].x * x1[i].x + x1[i].y * x1[i].y) + (x1[i].z * x1[i].z + x1[i].w * x1[i].w); }
        wave_sum4(sm);
        asm volatile("" ::: "memory");
#pragma unroll
        for (int i = 0; i < 4; ++i) { const int t = I.wave * 4 + i;
            const float rstd = rsq_(sm[i] * (1.0f / 512.0f) + EPS);
            const f32x4 y0 = x0[i] * rstd * lg0 + lb0, y1 = x1[i] * rstd * lg1 + lb1;
            v2u o0, o1; o0.x = pk2(siluf_(y0.x), siluf_(y0.y)); o0.y = pk2(siluf_(y0.z), siluf_(y0.w)); o1.x = pk2(siluf_(y1.x), siluf_(y1.y)); o1.y = pk2(siluf_(y1.z), siluf_(y1.w));
            LAS bf16* hrow = (LAS bf16*)(CO + t * 516);
            *(LAS v2u*)(hrow + I.lane * 4) = o0; *(LAS v2u*)(hrow + 256 + I.lane * 4) = o1; }
    }
    __syncthreads();
    const LAS bf16* HN = (const LAS bf16*)CO;
    f32x4 acc[2][4];
#pragma unroll
    for (int a = 0; a < 2; ++a)
#pragma unroll
        for (int b = 0; b < 4; ++b) acc[a][b] = (f32x4){0.f, 0.f, 0.f, 0.f};
#define CV_MMA(src, s) do { _Pragma("unroll") for (int ks = 0; ks < 4; ++ks) { const bf16x8 a0 = ldsfrag(HN + r * 1032 + ((s) * 4 + ks) * 32 + q * 8), a1 = ldsfrag(HN + (16 + r) * 1032 + ((s) * 4 + ks) * 32 + q * 8); \
        _Pragma("unroll") for (int b = 0; b < 4; ++b) { acc[0][b] = mfma16(src[ks][b], a0, acc[0][b]); acc[1][b] = mfma16(src[ks][b], a1, acc[1][b]); } } } while (0)
    CV_MMA(wA, 0); CV_LOAD(wA, 2); CV_MMA(wB, 1); CV_LOAD(wB, 3); CV_MMA(wA, 2); CV_MMA(wB, 3);
#undef CV_LOAD
#undef CV_MMA
#pragma unroll
    for (int a = 0; a < 2; ++a) { bf16* yp = P.Y + (size_t)(m0 + a * 16 + r) * D + Y_B + n0 + 16 * q;
        const f32x4 v0 = acc[a][0] + pb0, v1 = acc[a][1] + pb1, v2 = acc[a][2] + pb2, v3 = acc[a][3] + pb3;
        v4u o0, o1; o0.x = pk2(v0.x, v0.y); o0.y = pk2(v0.z, v0.w); o0.z = pk2(v1.x, v1.y); o0.w = pk2(v1.z, v1.w); o1.x = pk2(v2.x, v2.y); o1.y = pk2(v2.z, v2.w); o1.z = pk2(v3.x, v3.y); o1.w = pk2(v3.z, v3.w);
        *(v4u*)yp = o0; *(v4u*)(yp + 8) = o1; }
}

__device__ __forceinline__ void sgu_unit(Frame& F, int l, int u) {
    __syncthreads();
    const Ptrs P = load_ptrs(F); const Ids I = fresh_ids(F); LAS unsigned char* const L = fresh_lds(F.lds);
    LAS unsigned char* VI = L + RING_OFF;
    LAS bf16* RAWV = (LAS bf16*)(L + RING_OFF + 65536);
    const int hp = u & 1, ck = u >> 1, m0 = ck * 128;
    {
        float lg[8], lb[8];
        { const f32x4 g0 = *(const f32x4*)(P.sln_g + (size_t)l * 512 + I.lane * 8), g1 = *(const f32x4*)(P.sln_g + (size_t)l * 512 + I.lane * 8 + 4);
          const f32x4 b0 = *(const f32x4*)(P.sln_b + (size_t)l * 512 + I.lane * 8), b1 = *(const f32x4*)(P.sln_b + (size_t)l * 512 + I.lane * 8 + 4);
          lg[0] = g0.x; lg[1] = g0.y; lg[2] = g0.z; lg[3] = g0.w; lg[4] = g1.x; lg[5] = g1.y; lg[6] = g1.z; lg[7] = g1.w;
          lb[0] = b0.x; lb[1] = b0.y; lb[2] = b0.z; lb[3] = b0.w; lb[4] = b1.x; lb[5] = b1.y; lb[6] = b1.z; lb[7] = b1.w; }
        v4u rw[16];
#pragma unroll
        for (int i = 0; i < 16; ++i) { const int it = I.tid + 512 * i; rw[i] = *(const v4u*)(P.PROJ + (size_t)(m0 + (it >> 6)) * PN + C_SV + (it & 63) * 8); }
#pragma unroll
        for (int hf = 0; hf < 2; ++hf) {
            if (hf) __syncthreads();
#pragma unroll
            for (int i = 0; i < 8; ++i) { const int it = I.tid + 512 * i; *(LAS v4u*)(RAWV + (it >> 6) * 512 + (it & 63) * 8) = rw[hf * 8 + i]; }
            __syncthreads();
#pragma unroll 1
            for (int i = 0; i < 8; i += 2) { const int rl = I.wave * 8 + i, s = hf * 64 + rl;
                float x0[8], x1[8]; { const v4u w0 = *(const LAS v4u*)(RAWV + rl * 512 + I.lane * 8), w1 = *(const LAS v4u*)(RAWV + (rl + 1) * 512 + I.lane * 8); unpack8(w0, x0); unpack8(w1, x1); }
                float s0 = 0.f, q0 = 0.f, s1 = 0.f, q1 = 0.f;
#pragma unroll
                for (int e = 0; e < 8; ++e) {   s0 += x0[e]; q0 += x0[e] * x0[e]; s1 += x1[e]; q1 += x1[e] * x1[e]; }
#pragma unroll
                for (int o = 1; o < 64; o <<= 1) { s0 += __shfl_xor(s0, o); q0 += __shfl_xor(q0, o); s1 += __shfl_xor(s1, o); q1 += __shfl_xor(q1, o); }
                const float mean0 = s0 * (1.0f / 512.0f), mean1 = s1 * (1.0f / 512.0f);
                const float rstd0 = rsq_(fmaxf(q0 * (1.0f / 512.0f) - mean0 * mean0, 0.f) + EPS), rstd1 = rsq_(fmaxf(q1 * (1.0f / 512.0f) - mean1 * mean1, 0.f) + EPS);
                if ((I.lane >> 5) == hp) { const int hh = (I.lane & 31) >> 4, chn = I.lane & 15;
                    float y0[8], y1[8];
#pragma unroll
                    for (int e = 0; e < 8; ++e) { y0[e] = (x0[e] - mean0) * rstd0 * lg[e] + lb[e]; y1[e] = (x1[e] - mean1) * rstd1 * lg[e] + lb[e]; }
                    v4u o0, o1; o0.x = pk2(y0[0], y0[1]); o0.y = pk2(y0[2], y0[3]); o0.z = pk2(y0[4], y0[5]); o0.w = pk2(y0[6], y0[7]); o1.x = pk2(y1[0], y1[1]); o1.y = pk2(y1[2], y1[3]); o1.z = pk2(y1[4], y1[5]); o1.w = pk2(y1[6], y1[7]);
                    *(LAS v4u*)(VI + hh * 32768 + imgb_off(s, chn)) = o0; *(LAS v4u*)(VI + hh * 32768 + imgb_off(s + 1, chn)) = o1; }
            }
        }
    }
    __syncthreads();
    const int r = I.lane & 15, q = I.lane >> 4, t0 = I.wave * 16, t = t0 + r;
    bf16x8 wfa[2][4]; v2u uua[2][8]; float bsa[2];
#pragma unroll
    for (int hh = 0; hh < 2; ++hh) { const int h = 2 * hp + hh;
        const bf16* Ws = P.WsM + (size_t)(l * 4 + h) * 128 * 128 + (size_t)t * 128 + q * 8;
        const bf16* urow = P.PROJ + (size_t)(m0 + t) * PN + C_SU + h * 128 + 4 * q;
#pragma unroll
        for (int ks = 0; ks < 4; ++ks) wfa[hh][ks] = glbfrag(Ws + ks * 32);
#pragma unroll
        for (int c = 0; c < 8; ++c) uua[hh][c] = *(const v2u*)(urow + 16 * c);
        bsa[hh] = P.sgu_b[(size_t)(l * 4 + h) * 128 + t]; }
#pragma unroll
    for (int hh = 0; hh < 2; ++hh) { const int h = 2 * hp + hh;
        const bf16x8 (&wf)[4] = wfa[hh]; const v2u (&uu)[8] = uua[hh]; const float bs = bsa[hh];
        f32x4 G[8];
#pragma unroll
        for (int c = 0; c < 8; ++c) G[c] = (f32x4){0.f, 0.f, 0.f, 0.f};
#pragma unroll
        for (int ks = 0; ks < 4; ++ks)
#pragma unroll
            for (int c = 0; c < 8; ++c) G[c] = mfma16(trfrag(VI + hh * 32768, I.lane, c, ks), wf[ks], G[c]);
        bf16* yrow = P.Y + (size_t)(m0 + t) * D + Y_C + h * 128 + 4 * q;
#pragma unroll
        for (int c = 0; c < 8; ++c) { const float uv[4] = {bflo(uu[c].x), bfhi(uu[c].x), bflo(uu[c].y), bfhi(uu[c].y)};
            v2u o; o.x = pk2(uv[0] * (G[c][0] + bs), uv[1] * (G[c][1] + bs)); o.y = pk2(uv[2] * (G[c][2] + bs), uv[3] * (G[c][3] + bs));
            *(v2u*)(yrow + 16 * c) = o; }
    }
}

__device__ __forceinline__ void ssd_dt(Frame& F, const Ptrs& P, int l, int m0, int g, LAS float* acs, LAS float* dts, LAS float* tot) {
    const Ids I = fresh_ids(F);
    const int hh = I.tid >> 7, li = I.tid & 127, head = 4 * g + hh, half = I.wave & 1;
    const float dtr = P.DT[(size_t)(m0 + li) * 8 + head] + P.ssm_dtb[l * 8 + head];
    const float dtv = fmaxf(dtr, 0.f) + log1pf(expf(-fabsf(dtr)));
    float v = dtv * -expf(P.ssm_alog[l * 8 + head]);
#pragma unroll
    for (int o = 1; o < 64; o <<= 1) { const float t = __shfl_up(v, o); if (I.lane >= o) v += t; }
    if (I.lane == 63) tot[I.wave] = v;
    __syncthreads();
    if (half) v += tot[I.wave - 1];
    acs[hh * 128 + li] = v; dts[hh * 128 + li] = dtv;
    __syncthreads();
}
__device__ __forceinline__ void conv4_item(const Ptrs& P, int l, int m, int pos, int ch0, float (&o)[8]) {
    const float* cb = P.ssm_cb + (size_t)l * 1024 + ch0; const float* cw = P.ssm_cw + (size_t)l * 4096 + ch0;
    { const f32x4 b0 = *(const f32x4*)cb, b1 = *(const f32x4*)(cb + 4); o[0] = b0.x; o[1] = b0.y; o[2] = b0.z; o[3] = b0.w; o[4] = b1.x; o[5] = b1.y; o[6] = b1.z; o[7] = b1.w; }
#pragma unroll
    for (int k = 0; k < 4; ++k) if (pos - 3 + k >= 0) {
        const v4u w = *(const v4u*)(P.PROJ + (size_t)(m - 3 + k) * PN + C_XBC + ch0); float x[8]; unpack8(w, x);
        const f32x4 w0 = *(const f32x4*)(cw + k * 1024), w1 = *(const f32x4*)(cw + k * 1024 + 4);
        o[0] += w0.x * x[0]; o[1] += w0.y * x[1]; o[2] += w0.z * x[2]; o[3] += w0.w * x[3]; o[4] += w1.x * x[4]; o[5] += w1.y * x[5]; o[6] += w1.z * x[6]; o[7] += w1.w * x[7]; }
#pragma unroll
    for (int e = 0; e < 8; ++e) o[e] = siluf_(o[e]);
}
constexpr int SA_BI = 0, SA_XI = 32768, SA_ACS = 98304, SA_DTS = 100352, SA_TOT = 102400;
constexpr int SSD_CM = 0, SSD_BM = 34816, SSD_XI = 69632, SSD_ACS = 135168, SSD_DTS = 137216;
static_assert(SSD_DTS + 2048 <= RING_BYTES && SA_TOT + 64 <= RING_BYTES, "SSD LDS map");
__device__ __forceinline__ void ssdA_unit(Frame& F, int l, int u) {
    __syncthreads();
    const Ptrs P = load_ptrs(F); const Ids I = fresh_ids(F); LAS unsigned char* const L = fresh_lds(F.lds);
    LAS unsigned char* BI = L + RING_OFF + SA_BI;
    LAS unsigned char* XI = L + RING_OFF + SA_XI;
    LAS float* acs = (LAS float*)(L + RING_OFF + SA_ACS); LAS float* dts = (LAS float*)(L + RING_OFF + SA_DTS); LAS float* tot = (LAS float*)(L + RING_OFF + SA_TOT);
    const int g = u & 1, ck = u >> 1, b = ck >> 6, c = ck & 63, m0 = ck * 128, pos0 = c * 128;
    ssd_dt(F, P, l, m0, g, acs, dts, tot);
    { float* ag = P.ACS + (size_t)u * 1024; ag[I.tid] = acs[I.tid]; ag[512 + I.tid] = dts[I.tid]; }
    if (I.tid < 4) P.CD[(size_t)(b * NCH + c) * 8 + 4 * g + I.tid] = exp_(acs[I.tid * 128 + 127]);
#pragma unroll 4
    for (int i = 0; i < 16; ++i) {
        const int it = I.tid + 512 * i; int li, cg, ch0;
        if (i < 8) { li = it >> 5; cg = it & 31; ch0 = g * 256 + cg * 8; }
        else { const int j = it - (i < 12 ? 4096 : 6144); li = j >> 4; cg = j & 15; ch0 = (i < 12 ? 512 : 768) + g * 128 + cg * 8; }
        float o[8]; conv4_item(P, l, m0 + li, pos0 + li, ch0, o);
        v4u w; w.x = pk2(o[0], o[1]); w.y = pk2(o[2], o[3]); w.z = pk2(o[4], o[5]); w.w = pk2(o[6], o[7]);
        *(v4u*)(P.XBC + (size_t)(m0 + li) * 1024 + ch0) = w;
        if (i < 8) { const int hh = cg >> 3; const float fac = dts[hh * 128 + li] * exp_(acs[hh * 128 + 127] - acs[hh * 128 + li]);
            v4u ws; ws.x = pk2(o[0] * fac, o[1] * fac); ws.y = pk2(o[2] * fac, o[3] * fac); ws.z = pk2(o[4] * fac, o[5] * fac); ws.w = pk2(o[6] * fac, o[7] * fac);
            *(LAS v4u*)(XI + (hh >> 1) * 32768 + imgb_off(li, cg & 15)) = ws; }
        else if (i < 12) *(LAS v4u*)(BI + imgb_off(li, cg)) = w;
    }
    __syncthreads();
    const int r = I.lane & 15, q = I.lane >> 4, hh = I.wave >> 1, ph = (I.wave & 1) * 32;
    const LAS unsigned char* XIh = XI + (hh >> 1) * 32768; const int cx = (hh & 1) * 4 + (ph >> 4);
    f32x4 acc[2][8];
#pragma unroll
    for (int a = 0; a < 2; ++a)
#pragma unroll
        for (int n = 0; n < 8; ++n) acc[a][n] = (f32x4){0.f, 0.f, 0.f, 0.f};
#pragma unroll
    for (int ks = 0; ks < 4; ++ks) { const bf16x8 x0 = trfrag(XIh, I.lane, cx, ks), x1 = trfrag(XIh, I.lane, cx + 1, ks);
#pragma unroll
        for (int n = 0; n < 8; ++n) { const bf16x8 bn = trfrag(BI, I.lane, n, ks); acc[0][n] = mfma16(bn, x0, acc[0][n]); acc[1][n] = mfma16(bn, x1, acc[1][n]); } }
    float* st = P.STATES + ((size_t)((b * NCH + c) * 8 + 4 * g + hh) * 64) * 128;
#pragma unroll
    for (int a = 0; a < 2; ++a)
#pragma unroll
        for (int n = 0; n < 8; ++n) *(f32x4*)(st + (size_t)(ph + a * 16 + r) * 128 + n * 16 + 4 * q) = acc[a][n];
}
__device__ __forceinline__ void ssd_scan(Frame& F) {
    const Ptrs P = load_ptrs(F); const Ids I = fresh_ids(F);
    const int gt = fresh_bid() * (NWAVES * 64) + I.tid, NGT = F.G * NWAVES * 64;
#pragma unroll 1
    for (int e = gt; e < BATCH * 8 * 64 * 128; e += NGT) { const int pn = e & 8191, h = (e >> 13) & 7, b = e >> 16;
        float hs = 0.f;
#pragma unroll 1
        for (int c0 = 0; c0 < NCH; c0 += 32) {
            float sv[32], cd[32];
#pragma unroll
            for (int c = 0; c < 32; ++c) { sv[c] = P.STATES[((size_t)((b * NCH + c0 + c) * 8 + h) * 8192) + pn]; cd[c] = P.CD[(size_t)(b * NCH + c0 + c) * 8 + h]; }
#pragma unroll
            for (int c = 0; c < 32; ++c) { P.PREV[((size_t)((b * NCH + c0 + c) * 8 + h) * 8192) + pn] = (bf16)f2bf(hs); hs = hs * cd[c] + sv[c]; }
        }
    }
}
__device__ __forceinline__ void ssdC_unit(Frame& F, int l, int u) {
    __syncthreads();
    const Ptrs P = load_ptrs(F); const Ids I = fresh_ids(F); LAS unsigned char* const L = fresh_lds(F.lds);
    LAS bf16* CM = (LAS bf16*)(L + RING_OFF + SSD_CM);
    LAS bf16* BM = (LAS bf16*)(L + RING_OFF + SSD_BM);
    LAS unsigned char* XI = L + RING_OFF + SSD_XI;
    LAS float* acs = (LAS float*)(L + RING_OFF + SSD_ACS); LAS float* dts = (LAS float*)(L + RING_OFF + SSD_DTS);
    const int g = u & 1, ck = u >> 1, b = ck >> 6, c = ck & 63, m0 = ck * 128;
    const float dsk0 = P.ssm_d[l * 8 + 4 * g], dsk1 = P.ssm_d[l * 8 + 4 * g + 1], dsk2 = P.ssm_d[l * 8 + 4 * g + 2], dsk3 = P.ssm_d[l * 8 + 4 * g + 3];
    { const float* ag = P.ACS + (size_t)u * 1024; acs[I.tid] = ag[I.tid]; dts[I.tid] = ag[512 + I.tid]; }
    {
        v4u w[16];
#pragma unroll
        for (int i = 0; i < 16; ++i) { const int it = I.tid + 512 * i; int li, ch0;
            if (i < 8) { li = it >> 5; ch0 = g * 256 + (it & 31) * 8; } else { const int j = it - (i < 12 ? 4096 : 6144); li = j >> 4; ch0 = (i < 12 ? 512 : 768) + g * 128 + (j & 15) * 8; }
            w[i] = *(const v4u*)(P.XBC + (size_t)(m0 + li) * 1024 + ch0); }
#pragma unroll
        for (int i = 0; i < 16; ++i) { const int it = I.tid + 512 * i;
            if (i < 8) { const int li = it >> 5, cg = it & 31; *(LAS v4u*)(XI + (cg >> 4) * 32768 + imgb_off(li, cg & 15)) = w[i]; }
            else { const int j = it - (i < 12 ? 4096 : 6144), li = j >> 4, cg = j & 15; *(LAS v4u*)((i < 12 ? BM : CM) + li * 136 + cg * 8) = w[i]; } }
    }
    __syncthreads();
    const int r = I.lane & 15, q = I.lane >> 4, l0 = I.wave * 16, li = l0 + r;
    bf16x8 cf[4]; f32x4 cb[8];
#pragma unroll
    for (int n = 0; n < 8; ++n) cb[n] = (f32x4){0.f, 0.f, 0.f, 0.f};
#pragma unroll
    for (int ks = 0; ks < 4; ++ks) { cf[ks] = ldsfrag(CM + li * 136 + ks * 32 + q * 8);
#pragma unroll
        for (int n = 0; n < 8; ++n) cb[n] = mfma16(ldsfrag(BM + (n * 16 + r) * 136 + ks * 32 + q * 8), cf[ks], cb[n]); }
    __syncthreads();
    LAS bf16* Sw = BM + l0 * 136;
    float ssq = 0.f;
    const bf16* zrow = P.PROJ + (size_t)(m0 + li) * PN + C_Z + g * 256 + 4 * q;
    bf16* yrow = P.Y + (size_t)(m0 + li) * D + Y_D + g * 256 + 4 * q;
    const bf16* pv0 = P.PREV + ((size_t)((b * NCH + c) * 8 + 4 * g) * 64) * 128 + (size_t)r * 128 + q * 8;
    bf16x8 pf[4][4]; v2u zf[4];
#pragma unroll
    for (int cc = 0; cc < 4; ++cc) { zf[cc] = *(const v2u*)(zrow + cc * 16);
#pragma unroll
        for (int ks = 0; ks < 4; ++ks) pf[cc][ks] = glbfrag(pv0 + (size_t)cc * 16 * 128 + ks * 32); }
#pragma unroll 1
    for (int hh = 0; hh < 4; ++hh) { const int head = 4 * g + hh;
        bf16x8 cpf[4][4]; v2u czf[4];
#pragma unroll
        for (int cc = 0; cc < 4; ++cc) { czf[cc] = zf[cc];
#pragma unroll
            for (int ks = 0; ks < 4; ++ks) cpf[cc][ks] = pf[cc][ks]; }
        if (hh < 3) { const bf16* pvn = pv0 + (size_t)(hh + 1) * 64 * 128;
#pragma unroll
            for (int cc = 0; cc < 4; ++cc) { zf[cc] = *(const v2u*)(zrow + (hh + 1) * 64 + cc * 16);
#pragma unroll
                for (int ks = 0; ks < 4; ++ks) pf[cc][ks] = glbfrag(pvn + (size_t)cc * 16 * 128 + ks * 32); } }
        const float al = acs[hh * 128 + li];
        f32x4 yv[4];
#pragma unroll
        for (int cc = 0; cc < 4; ++cc) yv[cc] = (f32x4){0.f, 0.f, 0.f, 0.f};
#pragma unroll
        for (int ks = 0; ks < 4; ++ks)
#pragma unroll
            for (int cc = 0; cc < 4; ++cc) yv[cc] = mfma16(cpf[cc][ks], cf[ks], yv[cc]);
        { const float ea = exp_(al);
#pragma unroll
          for (int cc = 0; cc < 4; ++cc) yv[cc] = yv[cc] * ea; }
#pragma unroll
        for (int n = 0; n < 8; ++n) { const int s0 = n * 16 + 4 * q; const f32x4 as4 = *(const LAS f32x4*)(acs + hh * 128 + s0), ds4 = *(const LAS f32x4*)(dts + hh * 128 + s0);
            float v[4];
#pragma unroll
            for (int jj = 0; jj < 4; ++jj) v[jj] = (s0 + jj <= li) ? cb[n][jj] * exp_(fminf(al - as4[jj], 0.f)) * ds4[jj] : 0.f;
            v2u sw; sw.x = pk2(v[0], v[1]); sw.y = pk2(v[2], v[3]); *(LAS v2u*)(Sw + r * 136 + s0) = sw; }
        asm volatile("" ::: "memory");
        const LAS unsigned char* XIh = XI + (hh >> 1) * 32768;
#pragma unroll
        for (int ks = 0; ks < 4; ++ks) { const bf16x8 sa = ldsfrag(Sw + r * 136 + ks * 32 + q * 8);
#pragma unroll
            for (int cc = 0; cc < 4; ++cc) yv[cc] = mfma16(trfrag(XIh, I.lane, (hh & 1) * 4 + cc, ks), sa, yv[cc]); }
        asm volatile("" ::: "memory");
        const float dsk = hh == 0 ? dsk0 : hh == 1 ? dsk1 : hh == 2 ? dsk2 : dsk3;
#pragma unroll
        for (int cc = 0; cc < 4; ++cc) { const int pc = (hh & 1) * 64 + cc * 16 + 4 * q;
            const v2u xw = *(const LAS v2u*)(XIh + imgb_off(li, pc >> 3) + (pc & 7) * 2);
            const float xs[4] = {bflo(xw.x), bfhi(xw.x), bflo(xw.y), bfhi(xw.y)}, zz[4] = {bflo(czf[cc].x), bfhi(czf[cc].x), bflo(czf[cc].y), bfhi(czf[cc].y)};
            float yo[4];
#pragma unroll
            for (int jj = 0; jj < 4; ++jj) { yo[jj] = (yv[cc][jj] + xs[jj] * dsk) * zz[jj];     ssq += yo[jj] * yo[jj]; }
            v2u yw; yw.x = pk2(yo[0], yo[1]); yw.y = pk2(yo[2], yo[3]); *(v2u*)(yrow + hh * 64 + cc * 16) = yw; }
    }
    ssq += __shfl_xor(ssq, 16); ssq += __shfl_xor(ssq, 32);
    const float rs = rsq_(ssq * (1.0f / 256.0f) + EPS);
    asm volatile("s_waitcnt vmcnt(0)" ::: "memory");
    const float* ngp = P.ssm_norm + (size_t)l * 512 + g * 256 + 4 * q;
#pragma unroll
    for (int k = 0; k < 16; ++k) { const v2u yw = *(const v2u*)(yrow + k * 16); const f32x4 ng = *(const f32x4*)(ngp + k * 16);
        v2u o; o.x = pk2(bflo(yw.x) * rs * ng.x, bfhi(yw.x) * rs * ng.y); o.y = pk2(bflo(yw.y) * rs * ng.z, bfhi(yw.y) * rs * ng.w); *(v2u*)(yrow + k * 16) = o; }
}

struct Args { const float* in[31]; float* out; unsigned char* ws; };
__global__ void __launch_bounds__(NWAVES * 64, 2) mk_fwd(Args args) {
    extern __shared__ __attribute__((aligned(16))) unsigned char lds[];
    Frame F;
    F.lds = (LAS unsigned char*)lds;
    F.MISC = (volatile LAS unsigned*)(F.lds + MISC_OFF);
    F.G = gridDim.x; F.wave0 = __builtin_amdgcn_readfirstlane((int)(threadIdx.x >> 6));
    F.ctl = (gu32*)(args.ws + WS_CTL);
    for (int u = threadIdx.x; u < (LDS_BYTES - LDSCTL_OFF) / 4; u += NWAVES * 64) ((LAS unsigned*)(F.lds + LDSCTL_OFF))[u] = 0u;
    __syncthreads();
    if (threadIdx.x == 0) {
        LAS unsigned long long* tb = (LAS unsigned long long*)(F.lds + PTR_OFF);
#pragma unroll
        for (int i = 0; i < 31; ++i) tb[i] = (unsigned long long)args.in[i];
        tb[31] = (unsigned long long)args.out; tb[32] = (unsigned long long)args.ws;
    }
    __syncthreads();
    (void)xcd_barrier_post((unsigned*)(F.ctl + CW_BAR), F.MISC + 8);
#define GRID_BAR() do { XcdBarrier bb_; unsigned long long bp_ = (unsigned long long)(F.ctl + CW_BAR); asm volatile("" : "+s"(bp_)); bb_.bar = (unsigned*)(GAS unsigned*)bp_; bb_.x = xb_xcc_id(); bb_.st = F.MISC + 8; bb_.w0 = F.wave0; xcd_barrier(bb_); } while (0)

    const int NCV = (F.G >= 64 && F.G % 32 == 0) ? 64 * (F.G / 256 > 0 ? F.G / 256 : 1) : 0;
    { const Ids I0 = fresh_ids(F); convert_range(F, 0, NCV ? 2 * IT_FFN : IT_ALL, fresh_bid() * NWAVES + I0.wave, F.G * NWAVES); }
    prologue_small(F);
    { const Ptrs P = load_ptrs(F); row_phase<RP_FIRST>(F, P.x, P.H, P.SS, nullptr, nullptr, nullptr, nullptr); }
    GRID_BAR();
    {
        unsigned* cb_ = (unsigned*)(GAS unsigned*)(unsigned long long)(F.ctl + CW_BAR); bool even = (F.G % 8 == 0);
#pragma unroll
        for (int j = 0; j < 16; ++j) even = even && (xb_ld(&cb_[XB_XCNT(j)]) == (j < 8 ? (unsigned)F.G / 8u : 0u));
        const int rank = (int)F.MISC[10], xcc = (int)xb_xcc_id();
        F.vb = __builtin_amdgcn_readfirstlane(even ? rank * 8 + xcc : (int)blockIdx.x);
    }

#define FILL_ROWSCALE(ssp, S) \
    LAS float* rt_ = (LAS float*)(F.lds + RING_OFF + pg8::STAGE_BYTES);     \
    pg8::Unit u0_; u0_.pm = 0; u0_.pn = 0; (void)S.next(0, u0_); \
    { const Ids I_ = fresh_ids(F); __syncthreads(); if (I_.tid < 256) rt_[I_.tid] = rsq_((float)(ssp)[(size_t)u0_.pm * 256 + I_.tid] * (1.0f / (2048.0f * 1048576.0f)) + EPS); __syncthreads(); } \
    const pg8::RowScale R_{ssp, rt_, u0_.pm};
#pragma unroll 1
    for (int it = 0; it < 3 * NL; ++it) {
        const int l = it / 3, kind = it - 3 * l, f = kind >> 1;
        if (kind != 1) {
            const Ptrs P = load_ptrs(F);
            const int Gg = (it == 0) ? F.G - NCV : F.G;
            if (fresh_vb(F) >= Gg) { const Ids I0 = fresh_ids(F); convert_range(F, 2 * IT_FFN, IT_ALL, (fresh_vb(F) - Gg) * NWAVES + I0.wave, NCV * NWAVES); }
            else {
            pg8::Gemm g{P.H, P.Wgu + (size_t)(l * 2 + f) * (2 * FF) * D, M, 2 * FF, D}; pg8::StaticOrder S; S.init(M, 2 * FF, Gg, fresh_vb(F));
            const unsigned long long* ssp = P.SS + (size_t)it * M;
            FILL_ROWSCALE(ssp, S)
            pg8::EpiSwiGLU E{P.ACT, FF, R_};
            pg8::gemm_phase<pg8::EpiSwiGLU, pg8::StaticOrder, true, true>(F.lds + RING_OFF, g, S, E, F.wave0);
            }
            GRID_BAR();
        } else {
            {
                const Ptrs P = load_ptrs(F);
                row_phase<RP_DT>(F, nullptr, P.H, nullptr, nullptr, nullptr, P.WDT + (size_t)l * 16384, P.DT);
                pg8::Gemm g{P.H, P.Win + (size_t)l * PN * D, M, PN, D}; pg8::StaticOrder S; S.init(M, PN, F.G, fresh_vb(F));
                const unsigned long long* ssp = P.SS + (size_t)it * M;
                FILL_ROWSCALE(ssp, S)
                pg8::EpiBf16Rs E{P.PROJ, PN, R_};
                pg8::gemm_phase<pg8::EpiBf16Rs, pg8::StaticOrder, true, true>(F.lds + RING_OFF, g, S, E, F.wave0);
                GRID_BAR();
            }
            for (int u = fresh_bid(); u < 256; u += F.G) ssdA_unit(F, l, u);
            for (int u = fresh_bid(); u < 512; u += F.G) conv_unit<0>(F, l, u);
            for (int u = fresh_bid(); u < 256; u += F.G) sgu_unit(F, l, u);
            for (int u = fresh_bid(); u < 256; u += F.G) pool_unit(F, l, u);
            GRID_BAR();
            ssd_scan(F);
            GRID_BAR();
            for (int u = fresh_bid(); u < 256; u += F.G) ssdC_unit(F, l, u);
            GRID_BAR();
        }
        {
            const Ptrs P = load_ptrs(F);
            const bf16* A = kind != 1 ? P.ACT : P.Y; const bf16* Bt = kind != 1 ? P.Wd + (size_t)(l * 2 + f) * D * FF : P.Wout + (size_t)l * D * D;
            pg8::Gemm g{A, Bt, M, D, kind != 1 ? FF : D}; pg8::StaticOrder S; S.init(M, D, F.G, fresh_vb(F), 4);
            pg8::EpiResAdd E{P.H, D, kind != 1 ? 0.5f : 1.0f, it + 1 < 3 * NL ? P.SS + (size_t)(it + 1) * M : nullptr};
            pg8::gemm_phase<pg8::EpiResAdd, pg8::StaticOrder, true, true>(F.lds + RING_OFF, g, S, E, F.wave0);
            GRID_BAR();
        }
    }
#undef FILL_ROWSCALE
    { const Ptrs P = load_ptrs(F); row_phase<RP_FINAL>(F, nullptr, P.H, nullptr, P.final_norm, P.X, nullptr, nullptr); }
}

extern "C" void kernel_launch(void* const* d_in, const int* in_sizes, int n_in, void* d_out, int out_size, void* d_ws, size_t ws_size, hipStream_t stream) {
    static int grid = 0;
    if (grid == 0) {
        if (n_in != 31 || in_sizes[0] != M * D || out_size != M * D || ws_size < WS_END) { fprintf(stderr, "kernel_launch: unexpected shapes (n_in %d, in0 %d, out %d, ws %zu < %zu); nothing launched\n", n_in, n_in > 0 ? in_sizes[0] : -1, out_size, ws_size, (size_t)WS_END); grid = -1; return; }
        int dev = 0, cus = 0, per_cu = 0;
        if (hipGetDevice(&dev) != hipSuccess || hipDeviceGetAttribute(&cus, hipDeviceAttributeMultiprocessorCount, dev) != hipSuccess) { fprintf(stderr, "kernel_launch: device query failed\n"); grid = -1; return; }
        if (hipFuncSetAttribute((const void*)mk_fwd, hipFuncAttributeMaxDynamicSharedMemorySize, LDS_BYTES) != hipSuccess) { fprintf(stderr, "kernel_launch: hipFuncSetAttribute failed\n"); grid = -1; return; }
        if (hipOccupancyMaxActiveBlocksPerMultiprocessor(&per_cu, (const void*)mk_fwd, NWAVES * 64, LDS_BYTES) != hipSuccess || per_cu < 1) { fprintf(stderr, "kernel_launch: occupancy query reports %d blocks per CU\n", per_cu); }
        (void)hipGetLastError();
        grid = cus;
    }
    if (grid < 0) return;
    if (hipMemsetAsync((char*)d_ws + WS_CTL, 0, CTL_ZERO_BYTES, stream) != hipSuccess) { fprintf(stderr, "kernel_launch: memset failed\n"); return; }
    Args a{};
    for (int i = 0; i < 31; ++i) a.in[i] = (const float*)d_in[i];
    a.out = (float*)d_out; a.ws = (unsigned char*)d_ws;
    hipLaunchKernelGGL(mk_fwd, dim3(grid), dim3(NWAVES * 64), LDS_BYTES, stream, a);
    const hipError_t le = hipPeekAtLastError();
    if (le != hipSuccess) fprintf(stderr, "kernel_launch: launch failed: %s\n", hipGetErrorName(le));
}
```

```cpp
#include <hip/hip_runtime.h>
#include <cstdio>
#include <cstdint>
namespace pg8 {
#define PG8_LAS __attribute__((address_space(3)))
typedef unsigned short bf16_t;
typedef short bf16x8 __attribute__((ext_vector_type(8)));
typedef float f32x4 __attribute__((ext_vector_type(4)));
typedef unsigned u32x4 __attribute__((ext_vector_type(4)));
constexpr int BM = 256, BK = 64, HALF = 128, HTB = HALF * BK * 2  , STAGE_BYTES = 8 * HTB, NXCD = 8, WGM = 8;

__host__ __device__ __forceinline__ int lds_byte(int r, int c) { const int st = (r >> 4) * 2 + (c >> 5), rr = r & 15, cc = c & 31, ob = rr * 64 + cc * 2; return st * 1024 + (ob ^ (((ob >> 9) & 1) << 5)); }
__host__ __device__ __forceinline__ void stage_rc(int b, int& R, int& C) { const int st = b / 1024, sb = b % 1024, swz = sb ^ (((sb >> 9) & 1) << 5); R = (st >> 1) * 16 + swz / 64; C = (st & 1) * 32 + (swz % 64) / 2; }
__host__ __device__ __forceinline__ int perm32(int rho) { const int n = rho >> 4, i = rho & 15; return 8 * (i >> 2) + 4 * n + (i & 3); }

struct Unit { int pm, pn; };
struct Gemm { const bf16_t* A; const bf16_t* Bt; int M, N, K; };

struct StaticOrder {
    int nM, nN, nwg, G, c, wgm;
    __host__ __device__ void init(int M, int N, int G_, int c_, int wgm_ = WGM) { nM = M / BM; nN = N / BM; nwg = nM * nN; G = G_; c = c_; wgm = wgm_; }
    __host__ __device__ bool next(int i, Unit& u) const {
        const long L = (long)i * G + c; if (L >= nwg) return false;
        int wgid = (int)L; { const int q = nwg / NXCD, r = nwg % NXCD, xcd = wgid % NXCD, off = wgid / NXCD; wgid = (xcd < r ? xcd * (q + 1) : r * (q + 1) + (xcd - r) * q) + off; }
        const int nig = wgm * nN, gid = wgid / nig, fm = gid * wgm, gsz = (nM - fm) < wgm ? (nM - fm) : wgm;
        u.pm = fm + ((wgid % nig) % gsz); u.pn = (wgid % nig) / gsz; return true;
    }
    __device__ __forceinline__ void a_ready(const Unit&) const {}
    __device__ __forceinline__ void done(const Unit&) const {}
};
__device__ __forceinline__ unsigned cvt_pk_bf16(float lo, float hi) { unsigned r; asm volatile("v_cvt_pk_bf16_f32 %0, %1, %2" : "=v"(r) : "v"(lo), "v"(hi)); return r; }
typedef float f32x2 __attribute__((ext_vector_type(2)));
typedef __bf16 bf16x2v __attribute__((ext_vector_type(2)));
__device__ __forceinline__ unsigned pkbf(f32x2 v) { return __builtin_bit_cast(unsigned, __builtin_convertvector(v, bf16x2v)); }
struct RowScale {
    const unsigned long long* SS; const PG8_LAS float* rt; int pm0;
    __device__ __forceinline__ void load(float (&rs)[2][4], const Unit& u, int wr, int fr) const {
        if (u.pm == pm0) {
#pragma unroll
            for (int ai = 0; ai < 2; ++ai)
#pragma unroll
                for (int m = 0; m < 4; ++m) rs[ai][m] = rt[wr * 64 + fr + ai * HALF + m * 16];
        } else {
            const int row0 = u.pm * BM + wr * 64 + fr;
#pragma unroll
            for (int ai = 0; ai < 2; ++ai)
#pragma unroll
                for (int m = 0; m < 4; ++m) rs[ai][m] = __builtin_amdgcn_rsqf((float)SS[row0 + ai * HALF + m * 16] * (1.0f / (2048.0f * 1048576.0f)) + 1e-6f);
        }
    }
};
struct EpiSwiGLU {
    static constexpr bool PERM = true, AFTER_DRAIN = false, ZERO_C = true;
    bf16_t* O; int ldc; RowScale R;
    __device__ __forceinline__ void operator()(const f32x4 (&acc)[2][2][4][2], const Unit& u, int wr, int wc, int fr, int fq) const {
        const int row0 = u.pm * BM + wr * 64 + fr, col0 = u.pn * HALF + wc * 32 + 8 * fq;
        float rs[2][4]; R.load(rs, u, wr, fr);
#pragma unroll
        for (int ai = 0; ai < 2; ++ai)
#pragma unroll
            for (int m = 0; m < 4; ++m) { bf16_t* rowp = O + (size_t)(row0 + ai * HALF + m * 16) * ldc + col0;
                const float r = rs[ai][m], rr = r * r, rn = r * -1.44269504089f;
                unsigned wv[4];
#pragma unroll
                for (int n = 0; n < 2; ++n)
#pragma unroll
                    for (int jp = 0; jp < 2; ++jp) { const f32x2 a = {acc[ai][0][m][n][2 * jp], acc[ai][0][m][n][2 * jp + 1]}, b = {acc[ai][1][m][n][2 * jp], acc[ai][1][m][n][2 * jp + 1]};
                        const f32x2 t = a * b, ar = a * rn;
                        f32x2 e = {__builtin_amdgcn_exp2f(ar.x), __builtin_amdgcn_exp2f(ar.y)};
                        e = e + 1.0f;
                        const f32x2 sg = {__builtin_amdgcn_rcpf(e.x), __builtin_amdgcn_rcpf(e.y)};
                        wv[2 * n + jp] = pkbf((t * rr) * sg); }
                u32x4 w; w.x = wv[0]; w.y = wv[1]; w.z = wv[2]; w.w = wv[3];
                *(u32x4*)rowp = w; }
    }
};
struct EpiBf16Rs {
    static constexpr bool PERM = true, AFTER_DRAIN = false, ZERO_C = true;
    bf16_t* O; int ldc; RowScale R;
    template <int MODE> __device__ __forceinline__ void body(const f32x4 (&acc)[2][2][4][2], const float (&rs)[2][4], bf16_t* O0, const float ca, const float cb) const {
#pragma unroll
        for (int ai = 0; ai < 2; ++ai)
#pragma unroll
            for (int m = 0; m < 4; ++m) { bf16_t* rowp = O0 + (size_t)(ai * HALF + m * 16) * ldc; const float r = rs[ai][m];
#pragma unroll
                for (int bj = 0; bj < 2; ++bj) { unsigned wv[4];
                    f32x2 x[4], y[4], e[4];
#pragma unroll
                    for (int p = 0; p < 4; ++p) { x[p] = (f32x2){acc[ai][bj][m][p >> 1][2 * (p & 1)], acc[ai][bj][m][p >> 1][2 * (p & 1) + 1]}; x[p] = x[p] * r; }
                    if (MODE != 0) {
#pragma unroll
                        for (int p = 0; p < 4; ++p) y[p] = MODE == 1 ? x[p] * -1.44269504089f : x[p] * ((x[p] * x[p]) * cb + ca) * -1.44269504089f;
#pragma unroll
                        for (int p = 0; p < 4; ++p) e[p] = (f32x2){__builtin_amdgcn_exp2f(y[p].x), __builtin_amdgcn_exp2f(y[p].y)};
#pragma unroll
                        for (int p = 0; p < 4; ++p) e[p] = e[p] + 1.0f;
#pragma unroll
                        for (int p = 0; p < 4; ++p) e[p] = (f32x2){__builtin_amdgcn_rcpf(e[p].x), __builtin_amdgcn_rcpf(e[p].y)};
#pragma unroll
                        for (int p = 0; p < 4; ++p) x[p] = MODE == 1 ? e[p] : x[p] * e[p]; }
#pragma unroll
                    for (int p = 0; p < 4; ++p) wv[p] = pkbf(x[p]);
                    u32x4 w; w.x = wv[0]; w.y = wv[1]; w.z = wv[2]; w.w = wv[3];
                    *(u32x4*)(rowp + bj * HALF) = w; } }
    }
    __device__ __forceinline__ void operator()(const f32x4 (&acc)[2][2][4][2], const Unit& u, int wr, int wc, int fr, int fq) const {
        const int row0 = u.pm * BM + wr * 64 + fr, col0 = u.pn * BM + wc * 32 + 8 * fq;
        float rs[2][4]; R.load(rs, u, wr, fr);
        bf16_t* O0 = O + (size_t)row0 * ldc + col0;
        if (u.pn == 4 || u.pn == 5) body<1>(acc, rs, O0, 1.0f, 0.0f);
        else if (u.pn >= 6 && u.pn <= 11) { const bool ge = u.pn <= 9; body<2>(acc, rs, O0, ge ? 1.5957691216f : 1.0f, ge ? 0.0713548163f : 0.0f); }
        else body<0>(acc, rs, O0, 1.0f, 0.0f);
    }
};
struct EpiResAdd {
    static constexpr bool PERM = true, AFTER_DRAIN = false, ZERO_C = false;
    bf16_t* XB; int ldc; float s; unsigned long long* SS;
    __device__ __forceinline__ void operator()(const f32x4 (&acc)[2][2][4][2], const Unit& u, int wr, int wc, int fr, int fq) const {
        const int row0 = u.pm * BM + wr * 64 + fr, col0 = u.pn * BM + wc * 32 + 8 * fq;
        u32x4 o[2][4][2];
#pragma unroll
        for (int ai = 0; ai < 2; ++ai)
#pragma unroll
            for (int m = 0; m < 4; ++m)
#pragma unroll
                for (int bj = 0; bj < 2; ++bj) o[ai][m][bj] = *(const u32x4*)(XB + (size_t)(row0 + ai * HALF + m * 16) * ldc + col0 + bj * HALF);
#pragma unroll
        for (int ai = 0; ai < 2; ++ai)
#pragma unroll
            for (int m = 0; m < 4; ++m) { bf16_t* rowp = XB + (size_t)(row0 + ai * HALF + m * 16) * ldc + col0; float sq = 0.f;
#pragma unroll
                for (int bj = 0; bj < 2; ++bj) { const u32x4 ow = o[ai][m][bj]; const f32x4 a0 = acc[ai][bj][m][0] * s, a1 = acc[ai][bj][m][1] * s;
                    u32x4 w;
                    w.x = cvt_pk_bf16(__uint_as_float(ow.x << 16) + a0[0], __uint_as_float(ow.x & 0xffff0000u) + a0[1]); w.y = cvt_pk_bf16(__uint_as_float(ow.y << 16) + a0[2], __uint_as_float(ow.y & 0xffff0000u) + a0[3]);
                    w.z = cvt_pk_bf16(__uint_as_float(ow.z << 16) + a1[0], __uint_as_float(ow.z & 0xffff0000u) + a1[1]); w.w = cvt_pk_bf16(__uint_as_float(ow.w << 16) + a1[2], __uint_as_float(ow.w & 0xffff0000u) + a1[3]);
                    *(u32x4*)(rowp + bj * HALF) = w;
                    if (SS) {
#pragma unroll
                        for (int e = 0; e < 4; ++e) { const float lo = __uint_as_float(w[e] << 16), hi = __uint_as_float(w[e] & 0xffff0000u); sq += lo * lo + hi * hi; } } }
                if (SS) { sq += __shfl_xor(sq, 16); sq += __shfl_xor(sq, 32);
                    if (fq == 0) __hip_atomic_fetch_add(SS + row0 + ai * HALF + m * 16, (unsigned long long)(sq * 1048576.0f + 0.5f), __ATOMIC_RELAXED, __HIP_MEMORY_SCOPE_AGENT); } }
    }
};

struct NoPre { __device__ __forceinline__ void operator()(int) const {} };
struct FillRow { const unsigned long long* SS; PG8_LAS float* rt; int pm;
    __device__ __forceinline__ void operator()(int tid) const { if (tid < 256) rt[tid] = __builtin_amdgcn_rsqf((float)SS[(size_t)pm * 256 + tid] * (1.0f / (2048.0f * 1048576.0f)) + 1e-6f); } };
template <class Epi, class Sched, bool ALIGN_EPI = false, bool SP2 = false, class Pre = NoPre>
__device__ __forceinline__ void gemm_phase(PG8_LAS unsigned char* lds_in, const Gemm g, const Sched& S, const Epi& E, const int wave0, const Pre pre = Pre()) {
    PG8_LAS unsigned char* lds = lds_in; asm volatile("" : "+s"(lds));
    int wid_ = wave0; asm volatile("" : "+s"(wid_));
    unsigned msk_ = ~0u; asm volatile("" : "+s"(msk_));
    const int lane = (int)__builtin_amdgcn_mbcnt_hi(msk_, __builtin_amdgcn_mbcnt_lo(msk_, 0u)), wid = wid_, tid = wid * 64 + lane, wr = wid >> 2, wc = wid & 3, fr = lane & 15, fq = lane >> 4;
    const int K = g.K, nt = K / BK;
    unsigned voffA[2], voffB[2];
#pragma unroll
    for (int i = 0; i < 2; ++i) { int R, C; stage_rc(tid * 16 + i * 8192, R, C); const int Rb = Epi::PERM ? ((R & ~31) + perm32(R & 31)) : R;
        voffA[i] = (unsigned)(R * K + C) * 2u; voffB[i] = (unsigned)(Rb * K + C) * 2u; }
    const size_t kstep = (size_t)(BK * 2);
    const size_t hstep = (size_t)HALF * K * 2;
    const size_t tstep = 2 * hstep;
    const unsigned ldsw = (unsigned)wid * 1024u;
    const int aoff = lds_byte(wr * 64 + fr, fq * 8), boff = lds_byte(wc * 32 + fr, fq * 8);
#define PG8_SA(b, h) (((b) * 2 + (h)) * HTB)
#define PG8_SB(b, h) ((4 + (b) * 2 + (h)) * HTB)
#define PG8_STAGE(bufoff, gbase, voff) do { _Pragma("unroll") for (int _i = 0; _i < 2; ++_i) \
        __builtin_amdgcn_global_load_lds((const unsigned*)((const char*)(gbase) + (voff)[_i]), (PG8_LAS unsigned*)(lds + (bufoff) + ldsw + _i * 8192), 16, 0, 0); } while (0)
#define PG8_LDA(dst, b, h) do { _Pragma("unroll") for (int m = 0; m < 4; ++m) _Pragma("unroll") for (int k = 0; k < 2; ++k) dst[m][k] = *(const PG8_LAS bf16x8*)(lds + PG8_SA(b, h) + aoff + m * 2048 + k * 1024); } while (0)
#define PG8_LDB(dst, b, h) do { _Pragma("unroll") for (int n = 0; n < 2; ++n) _Pragma("unroll") for (int k = 0; k < 2; ++k) dst[n][k] = *(const PG8_LAS bf16x8*)(lds + PG8_SB(b, h) + boff + n * 2048 + k * 1024); } while (0)
#define PG8_MMA(ai, bj, At, Bt) do { __builtin_amdgcn_s_setprio(1); _Pragma("unroll") for (int m = 0; m < 4; ++m) _Pragma("unroll") for (int n = 0; n < 2; ++n) _Pragma("unroll") for (int k = 0; k < 2; ++k) \
        acc[ai][bj][m][n] = __builtin_amdgcn_mfma_f32_16x16x32_bf16(Bt[n][k], At[m][k], acc[ai][bj][m][n], 0, 0, 0); __builtin_amdgcn_s_setprio(0); } while (0)
#define PG8_MMA0(ai, bj, At, Bt) do { __builtin_amdgcn_s_setprio(1); _Pragma("unroll") for (int m = 0; m < 4; ++m) _Pragma("unroll") for (int n = 0; n < 2; ++n) { \
        acc[ai][bj][m][n] = __builtin_amdgcn_mfma_f32_16x16x32_bf16(Bt[n][0], At[m][0], (f32x4){0.f, 0.f, 0.f, 0.f}, 0, 0, 0); \
        acc[ai][bj][m][n] = __builtin_amdgcn_mfma_f32_16x16x32_bf16(Bt[n][1], At[m][1], acc[ai][bj][m][n], 0, 0, 0); } __builtin_amdgcn_s_setprio(0); } while (0)
#define PG8_WAIT_V(n) asm volatile("s_waitcnt vmcnt(" #n ")" ::: "memory")
#define PG8_WAIT_L(n) asm volatile("s_waitcnt lgkmcnt(" #n ")" ::: "memory")
#define PG8_BAR __builtin_amdgcn_s_barrier()
#define PG8_SCHED __builtin_amdgcn_sched_barrier(0)
    Unit cur, nxt; int ui = 0;
    if (!S.next(0, cur)) return;
    f32x4 acc[2][2][4][2];
    if constexpr (!(SP2 && Epi::ZERO_C)) {
#pragma unroll
    for (int a = 0; a < 2; ++a)
#pragma unroll
        for (int b = 0; b < 2; ++b)
#pragma unroll
            for (int m = 0; m < 4; ++m)
#pragma unroll
                for (int n = 0; n < 2; ++n) acc[a][b][m][n] = (f32x4){0.f, 0.f, 0.f, 0.f};
    }
    bf16x8 At[4][2], B0[2][2], B1[2][2];
    const char* cA = (const char*)g.A + (size_t)cur.pm * tstep; const char* cB = (const char*)g.Bt + (size_t)cur.pn * tstep;
    S.a_ready(cur);
    if constexpr (SP2) {
        PG8_STAGE(PG8_SB(0, 0), cB, voffB); PG8_STAGE(PG8_SB(0, 1), cB + hstep, voffB); PG8_STAGE(PG8_SA(0, 0), cA, voffA); PG8_STAGE(PG8_SA(0, 1), cA + hstep, voffA);
        pre(tid);
        if (wr == 1) PG8_BAR;
        PG8_WAIT_V(2); PG8_BAR;
        PG8_STAGE(PG8_SB(1, 0), cB + kstep, voffB); PG8_STAGE(PG8_SA(1, 0), cA + kstep, voffA); PG8_STAGE(PG8_SB(1, 1), cB + hstep + kstep, voffB);
        PG8_WAIT_V(6); PG8_BAR;
    } else {
        PG8_STAGE(PG8_SB(0, 0), cB, voffB); PG8_STAGE(PG8_SA(0, 0), cA, voffA); PG8_STAGE(PG8_SB(0, 1), cB + hstep, voffB); PG8_STAGE(PG8_SA(0, 1), cA + hstep, voffA);
        if (wr == 1) PG8_BAR;
        PG8_WAIT_V(4); PG8_BAR;
        PG8_STAGE(PG8_SB(1, 0), cB + kstep, voffB); PG8_STAGE(PG8_SA(1, 0), cA + kstep, voffA); PG8_STAGE(PG8_SB(1, 1), cB + hstep + kstep, voffB);
        PG8_WAIT_V(6); PG8_BAR;
    }
    for (;;) {
        const bool has_next = S.next(ui + 1, nxt);
        const char* nA = has_next ? (const char*)g.A + (size_t)nxt.pm * tstep : cA; const char* nB = has_next ? (const char*)g.Bt + (size_t)nxt.pn * tstep : cB;
        for (int t = 0; t < nt; t += 2) {
            const bool last = (t == nt - 2);
            const char* a1 = cA + (size_t)(t + 1) * kstep;
            const char* a2 = last ? nA : cA + (size_t)(t + 2) * kstep; const char* b2 = last ? nB : cB + (size_t)(t + 2) * kstep;
            const char* a3 = a2 + kstep; const char* b3 = b2 + kstep;
            if (last && has_next) S.a_ready(nxt);
            if constexpr (SP2) {
            PG8_LDB(B0, 0, 0); PG8_LDB(B1, 0, 1); PG8_SCHED; PG8_LDA(At, 0, 0); PG8_STAGE(PG8_SA(1, 1), a1 + hstep, voffA);
            PG8_WAIT_V(8); PG8_WAIT_L(0); PG8_BAR; if (Epi::ZERO_C && t == 0) { PG8_MMA0(0, 0, At, B0); PG8_MMA0(0, 1, At, B1); } else { PG8_MMA(0, 0, At, B0); PG8_MMA(0, 1, At, B1); } PG8_BAR; PG8_SCHED;
            PG8_LDA(At, 0, 1); PG8_STAGE(PG8_SB(0, 0), b2, voffB); PG8_STAGE(PG8_SB(0, 1), b2 + hstep, voffB); PG8_STAGE(PG8_SA(0, 0), a2, voffA);
            PG8_WAIT_V(8); PG8_WAIT_L(0); PG8_BAR; if (Epi::ZERO_C && t == 0) { PG8_MMA0(1, 0, At, B0); PG8_MMA0(1, 1, At, B1); } else { PG8_MMA(1, 0, At, B0); PG8_MMA(1, 1, At, B1); } PG8_BAR; PG8_SCHED;
            PG8_LDB(B0, 1, 0); PG8_LDB(B1, 1, 1); PG8_SCHED; PG8_LDA(At, 1, 0); PG8_STAGE(PG8_SA(0, 1), a2 + hstep, voffA);
            PG8_WAIT_V(8); PG8_WAIT_L(0); PG8_BAR; PG8_MMA(0, 0, At, B0); PG8_MMA(0, 1, At, B1); PG8_BAR; PG8_SCHED;
            PG8_LDA(At, 1, 1); PG8_STAGE(PG8_SB(1, 0), b3, voffB); PG8_STAGE(PG8_SB(1, 1), b3 + hstep, voffB); PG8_STAGE(PG8_SA(1, 0), a3, voffA);
            PG8_WAIT_V(8); PG8_WAIT_L(0); PG8_BAR; PG8_MMA(1, 0, At, B0); PG8_MMA(1, 1, At, B1); PG8_BAR; PG8_SCHED;
            } else {
            PG8_LDB(B0, 0, 0); PG8_SCHED; PG8_LDA(At, 0, 0); PG8_STAGE(PG8_SA(1, 1), a1 + hstep, voffA);
            PG8_WAIT_L(8); PG8_BAR; PG8_WAIT_L(0); PG8_MMA(0, 0, At, B0); PG8_BAR; PG8_SCHED;
            PG8_LDB(B1, 0, 1); PG8_STAGE(PG8_SB(0, 0), b2, voffB);
            PG8_BAR; PG8_WAIT_L(0); PG8_MMA(0, 1, At, B1); PG8_BAR;
            PG8_LDA(At, 0, 1); PG8_STAGE(PG8_SA(0, 0), a2, voffA);
            PG8_BAR; PG8_WAIT_L(0); PG8_MMA(1, 0, At, B0); PG8_BAR; PG8_SCHED;
            PG8_STAGE(PG8_SB(0, 1), b2 + hstep, voffB);
            PG8_WAIT_V(6); PG8_BAR; PG8_MMA(1, 1, At, B1); PG8_BAR;
            PG8_LDB(B0, 1, 0); PG8_SCHED; PG8_LDA(At, 1, 0); PG8_STAGE(PG8_SA(0, 1), a2 + hstep, voffA);
            PG8_WAIT_L(8); PG8_BAR; PG8_WAIT_L(0); PG8_MMA(0, 0, At, B0); PG8_BAR; PG8_SCHED;
            PG8_LDB(B1, 1, 1); PG8_STAGE(PG8_SB(1, 0), b3, voffB);
            PG8_BAR; PG8_WAIT_L(0); PG8_MMA(0, 1, At, B1); PG8_BAR;
            PG8_LDA(At, 1, 1); PG8_STAGE(PG8_SA(1, 0), a3, voffA);
            PG8_BAR; PG8_WAIT_L(0); PG8_MMA(1, 0, At, B0); PG8_BAR; PG8_SCHED;
            PG8_STAGE(PG8_SB(1, 1), b3 + hstep, voffB);
            PG8_WAIT_V(6); PG8_BAR; PG8_MMA(1, 1, At, B1); PG8_BAR;
            }
        }
        if constexpr (ALIGN_EPI) { if (wr == 0) PG8_BAR; }
        if constexpr (!Epi::AFTER_DRAIN) { E(acc, cur, wr, wc, fr, fq); S.done(cur); }
        if (!has_next) break;
        if constexpr (!(SP2 && Epi::ZERO_C)) {
#pragma unroll
        for (int a = 0; a < 2; ++a)
#pragma unroll
            for (int b = 0; b < 2; ++b)
#pragma unroll
                for (int m = 0; m < 4; ++m)
#pragma unroll
                    for (int n = 0; n < 2; ++n) acc[a][b][m][n] = (f32x4){0.f, 0.f, 0.f, 0.f};
        }
        cur = nxt; cA = nA; cB = nB; ++ui;
        if constexpr (ALIGN_EPI) { if (wr == 1) PG8_BAR; }
    }
    PG8_WAIT_V(0);
    if constexpr (!ALIGN_EPI) { if (wr == 0) PG8_BAR; }
    PG8_BAR;
    if constexpr (Epi::AFTER_DRAIN) { E.fused(acc, cur, wr, wc, fr, fq, lds, wid, lane); S.done(cur); }
#undef PG8_SA
#undef PG8_SB
#undef PG8_STAGE
#undef PG8_LDA
#undef PG8_LDB
#undef PG8_MMA
#undef PG8_MMA0
#undef PG8_WAIT_V
#undef PG8_WAIT_L
#undef PG8_BAR
#undef PG8_SCHED
}
}

constexpr int NWAVES = 8;
constexpr int BATCH = 2, SEQ = 8192, D = 2048, FF = 5632, NL = 4;
constexpr int M = BATCH * SEQ;
constexpr int INC = 4104;
constexpr int PN = 4096;
constexpr int C_A = 0, C_CVAL = 512, C_CGATE = 1024, C_SU = 1536, C_SV = 2048, C_Z = 2560, C_XBC = 3072;
constexpr int Y_A = 0, Y_B = 512, Y_C = 1024, Y_D = 1536;
constexpr float EPS = 1e-6f;
constexpr int NCH = SEQ / 128;

constexpr size_t MiB = 1u << 20;
constexpr size_t WS_CTL = 0, CTL_ZERO_BYTES = 32768;
constexpr size_t SZ_WGU = (size_t)2 * FF * D * 2, SZ_WD = (size_t)D * FF * 2, SZ_WIN = (size_t)PN * D * 2, SZ_WOUT = (size_t)D * D * 2;
constexpr size_t WS_WGU = 1 * MiB;
constexpr size_t WS_WD = WS_WGU + 2 * NL * SZ_WGU;
constexpr size_t WS_WIN = WS_WD + 2 * NL * SZ_WD;
constexpr size_t WS_WOUT = WS_WIN + NL * SZ_WIN;
constexpr size_t WS_POOLW = WS_WOUT + NL * SZ_WOUT;
constexpr size_t WS_PWT = WS_POOLW + (size_t)NL * 4 * 128 * 128 * 2;
constexpr size_t WS_WSM = WS_PWT + (size_t)NL * 512 * 512 * 2;
constexpr size_t WS_WDT = WS_WSM + (size_t)NL * 4 * 128 * 128 * 2;
constexpr size_t WS_SS = WS_WDT + (size_t)NL * 16384 * 4;
constexpr size_t WS_H = WS_SS + (size_t)3 * NL * M * 8;
constexpr size_t WS_DT = WS_H + (size_t)M * D * 2;
constexpr size_t WS_R = WS_DT + (size_t)M * 8 * 4;
constexpr size_t WS_ACT = WS_R;
constexpr size_t WS_PROJ = WS_R;
constexpr size_t WS_Y = WS_PROJ + (size_t)M * PN * 2;
constexpr size_t WS_STATES = WS_Y + (size_t)M * D * 2;
constexpr size_t WS_PREV = WS_STATES + (size_t)BATCH * NCH * 8 * 64 * 128 * 4;
constexpr size_t WS_CD = WS_PREV + (size_t)BATCH * NCH * 8 * 64 * 128 * 2;
constexpr size_t WS_XBC = WS_CD + 4096;
constexpr size_t WS_ACS = WS_XBC + (size_t)M * 1024 * 2;
constexpr size_t WS_MIXEND = WS_ACS + (size_t)256 * 1024 * 4;
constexpr size_t WS_END = WS_MIXEND > WS_ACT + (size_t)M * FF * 2 ? WS_MIXEND : WS_ACT + (size_t)M * FF * 2;
static_assert(WS_XBC % 256 == 0 && WS_ACS % 256 == 0 && WS_WGU % 256 == 0 && WS_WD % 256 == 0 && WS_WIN % 256 == 0 && WS_H % 256 == 0 && WS_R % 256 == 0 && WS_Y % 256 == 0 && WS_STATES % 256 == 0 && WS_PREV % 256 == 0, "alignment");
constexpr int CW_TMO = 0, CW_CODE = 1;
constexpr int CW_BAR = 4096;

constexpr int RING_OFF = 0, RING_BYTES = 147456;
constexpr int LDSCTL_OFF = RING_BYTES, MISC_OFF = LDSCTL_OFF + 320;
constexpr int LDS_BYTES = 151552;
static_assert(MISC_OFF + 128 <= LDS_BYTES, "LDS map");

#define GAS __attribute__((address_space(1)))
#define LAS __attribute__((address_space(3)))
typedef unsigned short bf16;
typedef unsigned v4u __attribute__((ext_vector_type(4)));
typedef unsigned v2u __attribute__((ext_vector_type(2)));
typedef float f32x4 __attribute__((ext_vector_type(4)));
typedef float f32x2 __attribute__((ext_vector_type(2)));
typedef short bf16x8 __attribute__((ext_vector_type(8)));
typedef GAS unsigned gu32;
#define RLX_AGENT __ATOMIC_RELAXED, __HIP_MEMORY_SCOPE_AGENT
#define LDS_WAIT() asm volatile("s_waitcnt lgkmcnt(0)" ::: "memory")
#define VM_WAIT() asm volatile("s_waitcnt vmcnt(0)" ::: "memory")
typedef __bf16 bf16x2_t __attribute__((ext_vector_type(2)));
__device__ __forceinline__ unsigned pk2(float lo, float hi) { const f32x2 v = {lo, hi}; const bf16x2_t b = __builtin_convertvector(v, bf16x2_t); return __builtin_bit_cast(unsigned, b); }
__device__ __forceinline__ unsigned f2bf(float f) { return pk2(f, 0.0f) & 0xffffu; }
__device__ __forceinline__ float bflo(unsigned u) { return __builtin_bit_cast(float, u << 16); }
__device__ __forceinline__ float bfhi(unsigned u) { return __builtin_bit_cast(float, u & 0xffff0000u); }
__device__ __forceinline__ float bf2f(bf16 b) { return __builtin_bit_cast(float, ((unsigned)b) << 16); }
__device__ __forceinline__ void unpack8(const v4u& w, float (&o)[8]) { o[0] = bflo(w.x); o[1] = bfhi(w.x); o[2] = bflo(w.y); o[3] = bfhi(w.y); o[4] = bflo(w.z); o[5] = bfhi(w.z); o[6] = bflo(w.w); o[7] = bfhi(w.w); }
__device__ __forceinline__ float rcp_(float x) { return __builtin_amdgcn_rcpf(x); }
__device__ __forceinline__ float rsq_(float x) { return __builtin_amdgcn_rsqf(x); }
__device__ __forceinline__ float exp_(float x) { return __builtin_amdgcn_exp2f(x * 1.44269504089f); }
__device__ __forceinline__ float sigmoidf_(float x) { return rcp_(1.0f + exp_(-x)); }
__device__ __forceinline__ float siluf_(float x) { return x * rcp_(1.0f + exp_(-x)); }
__device__ __forceinline__ float gelu_tanh(float x) { const float y2 = -2.0f * 0.7978845608028654f * (x + 0.044715f * x * x * x); return x * rcp_(1.0f + exp_(y2)); }
__device__ __forceinline__ f32x4 mfma16(bf16x8 a, bf16x8 b, f32x4 c) { return __builtin_amdgcn_mfma_f32_16x16x32_bf16(a, b, c, 0, 0, 0); }
__device__ __forceinline__ bf16x8 ldsfrag(const LAS bf16* p) { return *(const LAS bf16x8*)p; }
__device__ __forceinline__ bf16x8 glbfrag(const bf16* p) { return *(const bf16x8*)p; }
__device__ __forceinline__ unsigned imgb_off(unsigned row, unsigned ch) { return 256u * row + 16u * (ch ^ (((row & 3u) << 2) | ((row >> 2) & 3u))); }
__device__ __forceinline__ unsigned imgb_tr(unsigned lane, unsigned c, unsigned ks, unsigned t) { const unsigned g = lane >> 4, qq = (lane & 15u) >> 2, p = lane & 3u; return imgb_off(32u * ks + 8u * g + 4u * t + qq, 2u * c + (p >> 1)) + 8u * (p & 1u); }
typedef short s16x4 __attribute__((ext_vector_type(4)));
__device__ __forceinline__ bf16x8 trfrag(const LAS unsigned char* img, unsigned lane, unsigned c, unsigned ks) {
    const s16x4 lo = __builtin_amdgcn_ds_read_tr16_b64_v4i16((LAS s16x4*)(img + imgb_tr(lane, c, ks, 0u)));
    const s16x4 hi = __builtin_amdgcn_ds_read_tr16_b64_v4i16((LAS s16x4*)(img + imgb_tr(lane, c, ks, 1u)));
    return __builtin_shufflevector(lo, hi, 0, 1, 2, 3, 4, 5, 6, 7);
}

#define XB_TMO      128
#define XB_XCNT(j)  (256  + 64 * (j))
#define XB_XSUB(j)  (1280 + 64 * (j))
#define XB_XGEN(j)  (2304 + 64 * (j))
#define XB_TOP      3328
#define XB_TOPGEN   3392
#define XCD_BAR_WORDS 3456
#define XB_SPIN_CAP (1u << 18)

__device__ __forceinline__ unsigned xb_ld(unsigned* p)              { return __hip_atomic_load(p, __ATOMIC_RELAXED, __HIP_MEMORY_SCOPE_AGENT); }
__device__ __forceinline__ unsigned xb_add(unsigned* p, unsigned v) { return __hip_atomic_fetch_add(p, v, __ATOMIC_RELAXED, __HIP_MEMORY_SCOPE_AGENT); }
__device__ __forceinline__ unsigned xb_xcc_id() { return (unsigned)__builtin_amdgcn_s_getreg((3 << 11) | 20) & 0xFu; }
#define XB_SPIN(cond, bar) do { unsigned _sp = 0; while (cond) { __builtin_amdgcn_s_sleep(1); \
    if ((++_sp & 255u) == 0u) { if (xb_ld(&(bar)[XB_TMO])) break; if (_sp > XB_SPIN_CAP) { atomicAdd(&(bar)[XB_TMO], 1u); break; } } } } while (0)

struct XcdBarrier {
    unsigned* bar; unsigned x; int w0;
    volatile LAS unsigned* st;
};

__device__ __forceinline__ XcdBarrier xcd_barrier_post(unsigned* bar, volatile LAS unsigned* st) {
    XcdBarrier b; b.bar = bar; b.x = xb_xcc_id(); b.st = st; b.w0 = 0;
    if (threadIdx.x == 0) st[2] = xb_add(&bar[XB_XCNT(b.x)], 1u);
    return b;
}
__device__ __forceinline__ void xcd_barrier_complete(unsigned* bar, unsigned x, unsigned& nloc, unsigned& nx) {
    const unsigned G = gridDim.x * gridDim.y * gridDim.z;
    unsigned sum, cnt, mine, sp = 0u;
    for (;;) {
        sum = 0u; cnt = 0u; mine = 0u;
#pragma unroll
        for (unsigned j = 0; j < 16; ++j) { const unsigned c = xb_ld(&bar[XB_XCNT(j)]); sum += c; cnt += (c > 0u) ? 1u : 0u; mine = (j == x) ? c : mine; }
        if (sum == G) break;
        __builtin_amdgcn_s_sleep(1);
        if ((++sp & 255u) == 0u) { if (xb_ld(&bar[XB_TMO])) break; if (sp > XB_SPIN_CAP) { atomicAdd(&bar[XB_TMO], 1u); break; } }
    }
    nloc = mine > 0u ? mine : 1u; nx = cnt > 0u ? cnt : 1u;
}

__device__ __forceinline__ void xcd_barrier(const XcdBarrier& b) {
    asm volatile("s_waitcnt vmcnt(0)" ::: "memory");
    __syncthreads();
    unsigned xm_ = ~0u; asm volatile("" : "+s"(xm_));
    int xw_ = b.w0; asm volatile("" : "+s"(xw_));
    if (xw_ == 0 && __builtin_amdgcn_mbcnt_hi(xm_, __builtin_amdgcn_mbcnt_lo(xm_, 0u)) == 0u) {
        unsigned* bar = b.bar;
        __builtin_amdgcn_s_waitcnt(0);
        unsigned nloc = b.st[0], nx = b.st[1];
        if (nloc == 0u) { xcd_barrier_complete(bar, b.x, nloc, nx); b.st[0] = nloc; b.st[1] = nx; }
        const unsigned old = xb_add(&bar[XB_XSUB(b.x)], 1u);
        const unsigned gen = old / nloc;
        if (old + 1u == (gen + 1u) * nloc) {
            __builtin_amdgcn_fence(__ATOMIC_RELEASE, "agent");
            asm volatile("s_waitcnt vmcnt(0)" ::: "memory");
            const unsigned og = xb_add(&bar[XB_TOP], 1u);
            const unsigned tg = og / nx;
            if (og + 1u == (tg + 1u) * nx) xb_add(&bar[XB_TOPGEN], 1u);
            else XB_SPIN(xb_ld(&bar[XB_TOPGEN]) == tg, bar);
            __builtin_amdgcn_fence(__ATOMIC_ACQUIRE, "agent");
            xb_add(&bar[XB_XGEN(b.x)], 1u);
            asm volatile("s_waitcnt vmcnt(0)" ::: "memory");
        } else {
            XB_SPIN(xb_ld(&bar[XB_XGEN(b.x)]) == gen, bar);
            __builtin_amdgcn_fence(__ATOMIC_ACQUIRE, "agent");
            asm volatile("s_waitcnt vmcnt(0)" ::: "memory");
        }
    }
    __syncthreads();
}


struct Frame {
    LAS unsigned char* lds;
    volatile LAS unsigned* MISC;
    gu32* ctl;
    int G, wave0, vb;
};
struct Ids { int tid, lane, wave; };
__device__ __forceinline__ LAS unsigned char* fresh_lds(LAS unsigned char* p) { asm volatile("" : "+s"(p)); return p; }
__device__ __forceinline__ int fresh_lane() { unsigned m = ~0u; asm volatile("" : "+s"(m)); return (int)__builtin_amdgcn_mbcnt_hi(m, __builtin_amdgcn_mbcnt_lo(m, 0u)); }
__device__ __forceinline__ Ids fresh_ids(const Frame& F) { Ids r; r.lane = fresh_lane(); int w_ = F.wave0; asm volatile("" : "+s"(w_)); r.wave = w_; r.tid = r.wave * 64 + r.lane; return r; }
__device__ __forceinline__ void wave_sum4(float (&v)[4]) {
#pragma unroll
    for (int o = 1; o < 64; o <<= 1) { float t[4];
#pragma unroll
        for (int i = 0; i < 4; ++i) t[i] = __shfl_xor(v[i], o);
#pragma unroll
        for (int i = 0; i < 4; ++i) v[i] += t[i]; }
}
__device__ __forceinline__ float wave_sum(float v) {
#pragma unroll
    for (int o = 1; o < 64; o <<= 1) v += __shfl_xor(v, o);
    return v;
}

__device__ __forceinline__ void transpose_item(const float* W, int ldw, int KD, bf16* WT, int drow0, int k0, int n0, LAS float* scr, int lane, const float* kscale) {
    const int c = lane & 7;
    f32x4 g0 = {1.f, 1.f, 1.f, 1.f}, g1 = {1.f, 1.f, 1.f, 1.f};
    if (kscale) { g0 = *(const f32x4*)(kscale + k0 + 8 * c); g1 = *(const f32x4*)(kscale + k0 + 8 * c + 4); }
#pragma unroll 8
    for (int i = 0; i < 32; ++i) { const int kk = 2 * i + (lane >> 5); scr[kk * 33 + (lane & 31)] = W[(size_t)(k0 + kk) * ldw + n0 + (lane & 31)]; }
    LDS_WAIT(); asm volatile("" ::: "memory");
#pragma unroll
    for (int j = 0; j < 4; ++j) { const int n = (lane >> 3) + 8 * j; const LAS float* s = scr + (8 * c) * 33 + n;
        v4u o; o.x = pk2(s[0 * 33] * g0.x, s[1 * 33] * g0.y); o.y = pk2(s[2 * 33] * g0.z, s[3 * 33] * g0.w); o.z = pk2(s[4 * 33] * g1.x, s[5 * 33] * g1.y); o.w = pk2(s[6 * 33] * g1.z, s[7 * 33] * g1.w);
        *(GAS v4u*)(WT + (size_t)(drow0 + n) * KD + k0 + 8 * c) = o; }
    LDS_WAIT(); asm volatile("" ::: "memory");
}
struct Ptrs {
    const float *x, *ffn_norm[2], *ffn_wg[2], *ffn_wu[2], *ffn_wd[2], *mix_norm, *w_in, *pool_w, *pool_scale, *cdw_w, *cdw_b, *cln_g, *cln_b, *cpw_w, *cpw_b,
        *sln_g, *sln_b, *sgu_ws, *sgu_b, *ssm_cw, *ssm_cb, *ssm_dtb, *ssm_alog, *ssm_d, *ssm_norm, *w_out, *final_norm;
    float* X;
    bf16 *Wgu, *Wd, *Win, *Wout, *PoolW, *PwT, *WsM, *H, *ACT, *PROJ, *Y, *PREV;
    float *DT, *STATES, *CD, *ACS; bf16* WDB;
    unsigned long long* SS;
    bf16* XBC;
};
constexpr int PTR_OFF = MISC_OFF + 128;
static_assert(PTR_OFF + 33 * 8 <= LDS_BYTES, "LDS map");
__device__ __forceinline__ unsigned long long ldq(const LAS unsigned char* tbl, int i) { const LAS unsigned* t = (const LAS unsigned*)(tbl + PTR_OFF) + 2 * i;
    return ((unsigned long long)(unsigned)__builtin_amdgcn_readfirstlane((int)t[1]) << 32) | (unsigned long long)(unsigned)__builtin_amdgcn_readfirstlane((int)t[0]); }
__device__ __forceinline__ const float* inp(const LAS unsigned char* F, int i) { return (const float*)(const GAS float*)ldq(F, i); }
__device__ __forceinline__ int fresh_vb(const Frame& F) { int b = F.vb; asm volatile("" : "+s"(b)); return b; }
__device__ __forceinline__ int fresh_bid() { int b = blockIdx.x; asm volatile("" : "+s"(b)); return b; }
__device__ __forceinline__ Ptrs load_ptrs(const Frame& Fr) {
    const LAS unsigned char* F = Fr.lds; asm volatile("" : "+s"(F));
    Ptrs P;
    P.x = inp(F, 0);
    P.ffn_norm[0] = inp(F, 1); P.ffn_wg[0] = inp(F, 2); P.ffn_wu[0] = inp(F, 3); P.ffn_wd[0] = inp(F, 4);
    P.mix_norm = inp(F, 5); P.w_in = inp(F, 6); P.pool_w = inp(F, 7); P.pool_scale = inp(F, 8);
    P.cdw_w = inp(F, 9); P.cdw_b = inp(F, 10); P.cln_g = inp(F, 11); P.cln_b = inp(F, 12); P.cpw_w = inp(F, 13); P.cpw_b = inp(F, 14);
    P.sln_g = inp(F, 15); P.sln_b = inp(F, 16); P.sgu_ws = inp(F, 17); P.sgu_b = inp(F, 18);
    P.ssm_cw = inp(F, 19); P.ssm_cb = inp(F, 20); P.ssm_dtb = inp(F, 21); P.ssm_alog = inp(F, 22); P.ssm_d = inp(F, 23); P.ssm_norm = inp(F, 24);
    P.w_out = inp(F, 25);
    P.ffn_norm[1] = inp(F, 26); P.ffn_wg[1] = inp(F, 27); P.ffn_wu[1] = inp(F, 28); P.ffn_wd[1] = inp(F, 29);
    P.final_norm = inp(F, 30);
    P.X = (float*)(GAS float*)ldq(F, 31);
    unsigned char* ws = (unsigned char*)(GAS unsigned char*)ldq(F, 32);
    P.Wgu = (bf16*)(ws + WS_WGU); P.Wd = (bf16*)(ws + WS_WD); P.Win = (bf16*)(ws + WS_WIN); P.Wout = (bf16*)(ws + WS_WOUT);
    P.PoolW = (bf16*)(ws + WS_POOLW); P.PwT = (bf16*)(ws + WS_PWT); P.WsM = (bf16*)(ws + WS_WSM);
    P.H = (bf16*)(ws + WS_H); P.ACT = (bf16*)(ws + WS_ACT); P.PROJ = (bf16*)(ws + WS_PROJ); P.Y = (bf16*)(ws + WS_Y); P.PREV = (bf16*)(ws + WS_PREV);
    P.DT = (float*)(ws + WS_DT); P.STATES = (float*)(ws + WS_STATES); P.CD = (float*)(ws + WS_CD); P.ACS = (float*)(ws + WS_ACS); P.WDB = (bf16*)(ws + WS_WDT); P.SS = (unsigned long long*)(ws + WS_SS); P.XBC = (bf16*)(ws + WS_XBC);
    return P;
}
constexpr int IT_FFN = (D / 64) * (FF / 32);
constexpr int IT_WIN = (D / 64) * (PN / 32), IT_WOUT = (D / 64) * (D / 32);
constexpr int IT_PW = (512 / 64) * (512 / 32);
constexpr int IT_LAYER = 6 * IT_FFN + IT_WIN + IT_WOUT + IT_PW, IT_ALL = NL * IT_LAYER;
__device__ __forceinline__ void prologue_weights(Frame& F) {
    const Ptrs P = load_ptrs(F); const Ids I = fresh_ids(F);
    LAS unsigned char* const L = fresh_lds(F.lds);
    LAS float* scr = (LAS float*)(L + RING_OFF + I.wave * 16384);
    const int gw = fresh_bid() * NWAVES + I.wave, NGW = F.G * NWAVES;
    for (int it = gw; it < IT_ALL; it += NGW) {
        const int l = it / IT_LAYER; int r = it % IT_LAYER;
        if (r < 6 * IT_FFN) {
            const int f = r / (3 * IT_FFN); r -= f * 3 * IT_FFN; const int which = r / IT_FFN; r -= which * IT_FFN;
            if (which < 2) {
                const int nblk = FF / 32, kb = r / nblk, nb = r % nblk, n0 = 32 * nb;
                const float* W = (which == 0 ? (f ? P.ffn_wg[1] : P.ffn_wg[0]) : (f ? P.ffn_wu[1] : P.ffn_wu[0])) + (size_t)l * D * FF;
                bf16* WT = P.Wgu + (size_t)(l * 2 + f) * (2 * FF) * D;
                const int drow0 = (n0 >> 7) * 256 + (which ? 128 : 0) + (n0 & 127);
                transpose_item(W, FF, D, WT, drow0, 64 * kb, n0, scr, I.lane, (f ? P.ffn_norm[1] : P.ffn_norm[0]) + (size_t)l * D);
            } else {
                const int nblk = D / 32, kb = r / nblk, nb = r % nblk;
                const float* W = (f ? P.ffn_wd[1] : P.ffn_wd[0]) + (size_t)l * FF * D;
                bf16* WT = P.Wd + (size_t)(l * 2 + f) * D * FF;
                transpose_item(W, D, FF, WT, 32 * nb, 64 * kb, 32 * nb, scr, I.lane, nullptr);
            }
        } else {
            r -= 6 * IT_FFN;
            if (r < IT_WIN) { const int nblk = PN / 32, kb = r / nblk, nb = r % nblk;
                transpose_item(P.w_in + (size_t)l * D * INC, INC, D, P.Win + (size_t)l * PN * D, 32 * nb, 64 * kb, 32 * nb, scr, I.lane, P.mix_norm + (size_t)l * D);
            } else if (r < IT_WIN + IT_WOUT) { r -= IT_WIN; const int nblk = D / 32, kb = r / nblk, nb = r % nblk;
                transpose_item(P.w_out + (size_t)l * D * D, D, D, P.Wout + (size_t)l * D * D, 32 * nb, 64 * kb, 32 * nb, scr, I.lane, nullptr);
            } else { r -= IT_WIN + IT_WOUT; const int nblk = 512 / 32, kb = r / nblk, nb = r % nblk;
                transpose_item(P.cpw_w + (size_t)l * 512 * 512, 512, 512, P.PwT + (size_t)l * 512 * 512, 32 * nb, 64 * kb, 32 * nb, scr, I.lane, nullptr);
            }
        }
    }
    const int gt = fresh_bid() * (NWAVES * 64) + I.tid, NGT = F.G * NWAVES * 64;
    for (int i = gt; i < NL * 4 * 128 * 128; i += NGT) {
        const int c = i & 127, d = (i >> 7) & 127, lg = i >> 14;
        P.PoolW[i] = (bf16)f2bf(P.pool_w[((size_t)lg * 128 + c) * 128 + d] * P.pool_scale[(size_t)lg * 128 + d]);
        P.WsM[i] = (bf16)f2bf(c <= d ? P.sgu_ws[i] : 0.0f);
    }
    for (int i = gt; i < (3 * NL - 1) * M; i += NGT) P.SS[M + i] = 0ull;
    for (int i = gt; i < NL * 32768; i += NGT) {
        const int l = i >> 15, rem = i & 32767, ks = rem >> 9, r = (rem >> 5) & 15, k = ks * 32 + (rem & 31);
        const float w = P.mix_norm[(size_t)l * D + k] * P.w_in[((size_t)l * D + k) * INC + PN + (r & 7)];
        const unsigned hi = f2bf(w);
        P.WDB[i] = (bf16)(r < 8 ? hi : f2bf(w - bf2f((bf16)hi)));
    }
}

constexpr int RP_FIRST = 0, RP_DT = 1, RP_FINAL = 2;
template <int MODE>
__device__ __forceinline__ void row_phase(Frame& F, const float* xin, bf16* XB, unsigned long long* SS0, const float* gain, float* outf, const float* wdt  , float* DT) {
    const Ids I = fresh_ids(F);
    const int gw = fresh_bid() * NWAVES + I.wave, NGW = F.G * NWAVES;
    LAS unsigned char* const L = fresh_lds(F.lds);
    LAS float* wlA = (LAS float*)(L + RING_OFF);
    LAS float* wlB = (LAS float*)(L + RING_OFF + 32768);
    if (MODE == RP_DT) {
        __syncthreads();
        v4u tb[8];
#pragma unroll
        for (int i = 0; i < 8; ++i) tb[i] = *(const v4u*)(wdt + (size_t)(I.tid + 512 * i) * 4);
#pragma unroll
        for (int i = 0; i < 8; ++i) *(LAS v4u*)(wlA + (I.tid + 512 * i) * 4) = tb[i];
        __syncthreads();
    }
    f32x4 g[8];
    if (MODE == RP_FINAL) {
#pragma unroll
        for (int j = 0; j < 8; ++j) g[j] = ((const f32x4*)gain)[I.lane + 64 * j]; }
    if (MODE == RP_FIRST) {
        f32x4 nx[8];
        if (gw < M) { const f32x4* xr = (const f32x4*)(xin + (size_t)gw * D) + I.lane;
#pragma unroll
            for (int j = 0; j < 8; ++j) nx[j] = xr[64 * j]; }
#pragma unroll 1
        for (int m = gw; m < M; m += NGW) {
            f32x4 v[8];
#pragma unroll
            for (int j = 0; j < 8; ++j) v[j] = nx[j];
            if (m + NGW < M) { const f32x4* xr = (const f32x4*)(xin + (size_t)(m + NGW) * D) + I.lane;
#pragma unroll
                for (int j = 0; j < 8; ++j) nx[j] = xr[64 * j]; }
            float ss = 0.f; v2u* o8 = (v2u*)(XB + (size_t)m * D) + I.lane;
#pragma unroll
            for (int j = 0; j < 8; ++j) { v2u w; w.x = pk2(v[j].x, v[j].y); w.y = pk2(v[j].z, v[j].w); o8[64 * j] = w;
                const float a = bflo(w.x), b = bfhi(w.x), c = bflo(w.y), d = bfhi(w.y); ss += (a * a + b * b) + (c * c + d * d); }
            ss = wave_sum(ss);
            if (I.lane == 0) SS0[m] = (unsigned long long)(ss * 1048576.0f + 0.5f);
        }
    } else if (MODE == RP_FINAL) {
#pragma unroll 1
        for (int mb = gw; mb < M; mb += 4 * NGW) {
            v2u xc[4][8];
#pragma unroll
            for (int r = 0; r < 4; ++r) { const int m = mb + r * NGW;
#pragma unroll
                for (int j = 0; j < 8; ++j) xc[r][j] = (v2u){0u, 0u};
                if (m < M) { const v2u* xr = (const v2u*)(XB + (size_t)m * D) + I.lane;
#pragma unroll
                    for (int j = 0; j < 8; ++j) xc[r][j] = xr[64 * j]; } }
            float ss[4];
#pragma unroll
            for (int r = 0; r < 4; ++r) { ss[r] = 0.f;
#pragma unroll
                for (int j = 0; j < 8; ++j) { const float a = bflo(xc[r][j].x), b = bfhi(xc[r][j].x), c = bflo(xc[r][j].y), d = bfhi(xc[r][j].y); ss[r] += (a * a + b * b) + (c * c + d * d); } }
            wave_sum4(ss);
#pragma unroll
            for (int r = 0; r < 4; ++r) { const int m = mb + r * NGW;
                const float rstd = 1.0f / sqrtf(ss[r] * (1.0f / D) + EPS);
                if (m < M) { f32x4* o = (f32x4*)(outf + (size_t)m * D) + I.lane;
#pragma unroll
                    for (int j = 0; j < 8; ++j) { const f32x4 v = {bflo(xc[r][j].x), bfhi(xc[r][j].x), bflo(xc[r][j].y), bfhi(xc[r][j].y)}; o[64 * j] = v * rstd * g[j]; } } }
        }
    } else {
        v2u nx[8];
        if (gw < M) { const v2u* xr = (const v2u*)(XB + (size_t)gw * D) + I.lane;
#pragma unroll
            for (int j = 0; j < 8; ++j) nx[j] = xr[64 * j]; }
#pragma unroll 1
        for (int m = gw; m < M; m += NGW) {
            f32x4 v[8]; float ss = 0.f;
#pragma unroll
            for (int j = 0; j < 8; ++j) { v[j] = (f32x4){bflo(nx[j].x), bfhi(nx[j].x), bflo(nx[j].y), bfhi(nx[j].y)}; ss += (v[j].x * v[j].x + v[j].y * v[j].y) + (v[j].z * v[j].z + v[j].w * v[j].w); }
            if (m + NGW < M) { const v2u* xr = (const v2u*)(XB + (size_t)(m + NGW) * D) + I.lane;
#pragma unroll
                for (int j = 0; j < 8; ++j) nx[j] = xr[64 * j]; }
            const float rstd = 1.0f / sqrtf(wave_sum(ss) * (1.0f / D) + EPS);
            if (MODE == RP_DT) {
                f32x4 a0 = {0.f, 0.f, 0.f, 0.f}, a1 = {0.f, 0.f, 0.f, 0.f};
#pragma unroll
                for (int j = 0; j < 8; ++j) { asm volatile("" ::: "memory");
#pragma unroll
                    for (int i = 0; i < 4; ++i) { const int slot = (j * 4 + i) * 64 + I.lane; const f32x4 w0 = *(const LAS f32x4*)(wlA + slot * 4), w1 = *(const LAS f32x4*)(wlB + slot * 4); const float xv = v[j][i]; a0 += w0 * xv; a1 += w1 * xv; } }
                float r8[8] = {a0.x, a0.y, a0.z, a0.w, a1.x, a1.y, a1.z, a1.w};
#pragma unroll
                for (int e = 0; e < 8; ++e) r8[e] = wave_sum(r8[e]) * rstd;
                if (I.lane == 0) { f32x4* dp = (f32x4*)(DT + (size_t)m * 8); dp[0] = (f32x4){r8[0], r8[1], r8[2], r8[3]}; dp[1] = (f32x4){r8[4], r8[5], r8[6], r8[7]}; }
            } else { f32x4* o = (f32x4*)(outf + (size_t)m * D) + I.lane;
#pragma unroll
                for (int j = 0; j < 8; ++j) o[64 * j] = v[j] * rstd * g[j]; }
        }
    }
}

__device__ __forceinline__ void dt_phase(Frame& F, int l, const unsigned long long* ssp) {
    __syncthreads();
    const Ptrs P = load_ptrs(F); const Ids I = fresh_ids(F); LAS unsigned char* const L = fresh_lds(F.lds);
    LAS bf16* TB = (LAS bf16*)(L + RING_OFF);
    LAS float* CB = (LAS float*)(L + RING_OFF + 65536);
    {   v4u tb[8]; const v4u* src = (const v4u*)(P.WDB + (size_t)l * 32768);
#pragma unroll
        for (int i = 0; i < 8; ++i) tb[i] = src[I.tid + 512 * i];
#pragma unroll
        for (int i = 0; i < 8; ++i) ((LAS v4u*)TB)[I.tid + 512 * i] = tb[i]; }
    __syncthreads();
    const int r = I.lane & 15, q = I.lane >> 4, t = I.wave >> 1, h = I.wave & 1;
#pragma unroll 1
    for (int rb = fresh_bid() * 64; rb < M; rb += F.G * 64) {
        const int row = rb + 16 * t + r;
        const bf16* xp = P.H + (size_t)row * D + 1024 * h + 8 * q;
        f32x4 acc = {0.f, 0.f, 0.f, 0.f};
#pragma unroll
        for (int bt = 0; bt < 2; ++bt) { bf16x8 xf[16];
#pragma unroll
            for (int sx = 0; sx < 16; ++sx) xf[sx] = glbfrag(xp + (bt * 16 + sx) * 32);
#pragma unroll
            for (int sx = 0; sx < 16; ++sx) { const int ks = 32 * h + 16 * bt + sx; acc = mfma16(ldsfrag(TB + (ks * 16 + r) * 32 + 8 * q), xf[sx], acc); } }
        if (h == 1) *(LAS f32x4*)(CB + (t * 64 + I.lane) * 4) = acc;
        __syncthreads();
        if (h == 0) { const f32x4 o = *(const LAS f32x4*)(CB + (t * 64 + I.lane) * 4); acc = acc + o;
            f32x4 lo; lo.x = __shfl_xor(acc.x, 32); lo.y = __shfl_xor(acc.y, 32); lo.z = __shfl_xor(acc.z, 32); lo.w = __shfl_xor(acc.w, 32);
            const float rstd = 1.0f / sqrtf((float)ssp[row] * (1.0f / (2048.0f * 1048576.0f)) + EPS);
            if (q < 2) *(f32x4*)(P.DT + (size_t)row * 8 + 4 * q) = (acc + lo) * rstd; }
        __syncthreads();
    }
}

__device__ __forceinline__ int pc32(int b, int i) { return 32 * (i >> 2) + 4 * b + (i & 3); }
__device__ __forceinline__ int pc16(int b, int i) { return 16 * (i >> 2) + 4 * b + (i & 3); }
__device__ __forceinline__ void pool_unit(Frame& F, int l, int u) {
    __syncthreads();
    const Ptrs P = load_ptrs(F); const Ids I = fresh_ids(F); LAS unsigned char* const L = fresh_lds(F.lds);
    LAS bf16* RAW = (LAS bf16*)(L + RING_OFF);
    LAS bf16* Pl = (LAS bf16*)(L + RING_OFF + 80896);
    static_assert(80896 + 64 * 520 * 2 <= RING_BYTES, "pool LDS map");
    const int m0 = u * 64, pos0 = m0 & (SEQ - 1);
    const int r = I.lane & 15, q = I.lane >> 4, gq = I.wave >> 1, ch = (I.wave & 1) * 64;
    {
        v4u rw[10];
#pragma unroll
        for (int i = 0; i < 10; ++i) { const int it = I.tid + 512 * i, jr = it >> 6, cg = it & 63; rw[i] = (v4u){0u, 0u, 0u, 0u};
            if (it < 79 * 64 && pos0 + jr - 15 >= 0) rw[i] = *(const v4u*)(P.PROJ + (size_t)(m0 + jr - 15) * PN + C_A + cg * 8); }
#pragma unroll
        for (int i = 0; i < 10; ++i) { const int it = I.tid + 512 * i; if (it < 79 * 64) *(LAS v4u*)(RAW + (it >> 6) * 512 + (it & 63) * 8) = rw[i]; }
    }
    bf16x8 wf[4][4];
    { const bf16* Wt = P.PoolW + (size_t)(l * 4 + gq) * 128 * 128 + q * 8;
#pragma unroll
      for (int ks = 0; ks < 4; ++ks)
#pragma unroll
          for (int b = 0; b < 4; ++b) wf[ks][b] = glbfrag(Wt + (size_t)(ch + pc16(b, r)) * 128 + ks * 32); }
    __syncthreads();
    { const int win = 2 << gq, th = I.wave & 1;
#pragma unroll 1
      for (int i = 0; i < 8; ++i) { const int it = I.lane + 64 * i, t = 32 * th + (it >> 4), c = it & 15, pos = pos0 + t;
          const LAS bf16* rp = RAW + (t + 15) * 512 + gq * 128 + c * 8;
          float cur[8], sum[8]; { const v4u w = *(const LAS v4u*)rp; unpack8(w, cur); }
#pragma unroll
          for (int e = 0; e < 8; ++e) sum[e] = cur[e];
#pragma unroll 1
          for (int k = 1; k < win; ++k) { const v4u w = *(const LAS v4u*)(rp - k * 512); float x[8]; unpack8(w, x);
#pragma unroll
              for (int e = 0; e < 8; ++e) sum[e] += x[e]; }
          const float inv = rcp_((float)(pos + 1 < win ? pos + 1 : win));
          v4u o; o.x = pk2(sum[0] * inv - cur[0], sum[1] * inv - cur[1]); o.y = pk2(sum[2] * inv - cur[2], sum[3] * inv - cur[3]);
          o.z = pk2(sum[4] * inv - cur[4], sum[5] * inv - cur[5]); o.w = pk2(sum[6] * inv - cur[6], sum[7] * inv - cur[7]);
          *(LAS v4u*)(Pl + t * 520 + gq * 128 + c * 8) = o; } }
    __syncthreads();
#pragma unroll 1
    for (int a = 0; a < 4; ++a) {
        f32x4 acc[4];
#pragma unroll
        for (int b = 0; b < 4; ++b) acc[b] = (f32x4){0.f, 0.f, 0.f, 0.f};
#pragma unroll
        for (int ks = 0; ks < 4; ++ks) { const bf16x8 af = ldsfrag(Pl + (a * 16 + r) * 520 + gq * 128 + ks * 32 + q * 8);
#pragma unroll
            for (int b = 0; b < 4; ++b) acc[b] = mfma16(wf[ks][b], af, acc[b]); }
        bf16* yp = P.Y + (size_t)(m0 + a * 16 + r) * D + Y_A + gq * 128 + ch + 16 * q;
        v4u o0, o1; o0.x = pk2(acc[0].x, acc[0].y); o0.y = pk2(acc[0].z, acc[0].w); o0.z = pk2(acc[1].x, acc[1].y); o0.w = pk2(acc[1].z, acc[1].w);
        o1.x = pk2(acc[2].x, acc[2].y); o1.y = pk2(acc[2].z, acc[2].w); o1.z = pk2(acc[3].x, acc[3].y); o1.w = pk2(acc[3].z, acc[3].w);
        *(v4u*)yp = o0; *(v4u*)(yp + 8) = o1; }
}

template <int COPY> __device__ __forceinline__ void conv_unit(Frame& F, int l, int u) {
    __syncthreads();
    const Ptrs P = load_ptrs(F); const Ids I = fresh_ids(F); LAS unsigned char* const L = fresh_lds(F.lds);
    LAS bf16* GL = (LAS bf16*)(L + RING_OFF);
    LAS float* CO = (LAS float*)(L + RING_OFF + 65536);
    const int m0 = u * 32, pos0 = m0 & (SEQ - 1);
    const int cp = I.tid & 255, th = I.tid >> 8;
    f32x2 w[31];
#pragma unroll
    for (int k = 0; k < 31; ++k) w[k] = *(const f32x2*)(P.cdw_w + ((size_t)l * 31 + k) * 512 + 2 * cp);
    const f32x2 b2 = *(const f32x2*)(P.cdw_b + (size_t)l * 512 + 2 * cp);
    {
        v4u vv[8], gg[8];
#pragma unroll
        for (int i = 0; i < 8; ++i) { const int it = I.tid + 512 * i, jr = it >> 6, cg = it & 63;
            vv[i] = (v4u){0u, 0u, 0u, 0u}; gg[i] = (v4u){0u, 0u, 0u, 0u};
            if (it < 62 * 64 && pos0 + jr - 30 >= 0) { const bf16* rowp = P.PROJ + (size_t)(m0 + jr - 30) * PN + cg * 8; vv[i] = *(const v4u*)(rowp + C_CVAL); gg[i] = *(const v4u*)(rowp + C_CGATE); } }
#pragma unroll
        for (int i = 0; i < 8; ++i) { const int it = I.tid + 512 * i, jr = it >> 6, cg = it & 63;
            if (it < 62 * 64) { float a[8], b[8]; unpack8(vv[i], a); unpack8(gg[i], b);
                v4u o; o.x = pk2(a[0] * b[0], a[1] * b[1]); o.y = pk2(a[2] * b[2], a[3] * b[3]);
                o.z = pk2(a[4] * b[4], a[5] * b[5]); o.w = pk2(a[6] * b[6], a[7] * b[7]);
                *(LAS v4u*)(GL + jr * 512 + cg * 8) = o; } }
    }
    __syncthreads();
    {
#pragma unroll 1
        for (int g8 = 0; g8 < 2; ++g8) { const int t0 = 16 * th + 8 * g8;
            f32x2 acc[8] = {b2, b2, b2, b2, b2, b2, b2, b2};
            const LAS bf16* gp = GL + t0 * 512 + 2 * cp;
            unsigned gw[38];
#pragma unroll
            for (int j = 0; j < 38; ++j) gw[j] = *(const LAS unsigned*)(gp + j * 512);
#pragma unroll
            for (int j = 0; j < 38; ++j) { const f32x2 gv = {bflo(gw[j]), bfhi(gw[j])};
#pragma unroll
                for (int t = 0; t < 8; ++t) { const int k = j - t; if (k >= 0 && k <= 30) acc[t] += w[k] * gv; } }
#pragma unroll
            for (int t = 0; t < 8; ++t) *(LAS f32x2*)(CO + (t0 + t) * 516 + 2 * cp) = acc[t]; }
    }
    const int r = I.lane & 15, q = I.lane >> 4, n0 = I.wave * 64;
    const bf16* Wt = P.PwT + (size_t)l * 512 * 512 + q * 8;
    bf16x8 wA[4][4], wB[4][4];
#define CV_LOAD(dst, s) do { _Pragma("unroll") for (int ks = 0; ks < 4; ++ks) _Pragma("unroll") for (int b = 0; b < 4; ++b) dst[ks][b] = glbfrag(Wt + (size_t)(n0 + pc16(b, r)) * 512 + ((s) * 4 + ks) * 32); } while (0)
    const f32x4 lg0 = *(const f32x4*)(P.cln_g + (size_t)l * 512 + I.lane * 4), lg1 = *(const f32x4*)(P.cln_g + (size_t)l * 512 + 256 + I.lane * 4);
    const f32x4 lb0 = *(const f32x4*)(P.cln_b + (size_t)l * 512 + I.lane * 4), lb1 = *(const f32x4*)(P.cln_b + (size_t)l * 512 + 256 + I.lane * 4);
    CV_LOAD(wA, 0); CV_LOAD(wB, 1);
    const float* pbp = P.cpw_b + (size_t)l * 512 + n0 + 16 * q;
    const f32x4 pb0 = *(const f32x4*)pbp, pb1 = *(const f32x4*)(pbp + 4), pb2 = *(const f32x4*)(pbp + 8), pb3 = *(const f32x4*)(pbp + 12);
    __syncthreads();
    {
        f32x4 x0[4], x1[4]; float sm[4];
#pragma unroll
        for (int i = 0; i < 4; ++i) { const int t = I.wave * 4 + i;
            x0[i] = *(const LAS f32x4*)(CO + t * 516 + I.lane * 4); x1[i] = *(const LAS f32x4*)(CO + t * 516 + 256 + I.lane * 4);
            sm[i] = (x0[i].x + x0[i].y) + (x0[i].z + x0[i].w) + (x1[i].x + x1[i].y) + (x1[i].z + x1[i].w); }
        wave_sum4(sm);
#pragma unroll
        for (int i = 0; i < 4; ++i) { const float mean = sm[i] * (1.0f / 512.0f);
            x0[i] = x0[i] - mean; x1[i] = x1[i] - mean;
            sm[i] = (x0[i].x * x0[i].x + x0[i].y * x0[i].y) + (x0[i].z * x0[i].z + x0[i].w * x0[i].w) + (x1[i].x * x1[i].x + x1[i].y * x1[i].y) + (x1[i].z * x1[i].z + x1[i].w * x1[i].w); }
        wave_sum4(sm);
        asm volatile("" ::: "memory");
#pragma unroll
        for (int i = 0; i < 4; ++i) { const int t = I.wave * 4 + i;
            const float rstd = rsq_(sm[i] * (1.0f / 512.0f) + EPS);
            const f32x4 y0 = x0[i] * rstd * lg0 + lb0, y1 = x1[i] * rstd * lg1 + lb1;
            v2u o0, o1; o0.x = pk2(siluf_(y0.x), siluf_(y0.y)); o0.y = pk2(siluf_(y0.z), siluf_(y0.w)); o1.x = pk2(siluf_(y1.x), siluf_(y1.y)); o1.y = pk2(siluf_(y1.z), siluf_(y1.w));
            LAS bf16* hrow = (LAS bf16*)(CO + t * 516);
            *(LAS v2u*)(hrow + I.lane * 4) = o0; *(LAS v2u*)(hrow + 256 + I.lane * 4) = o1; }
    }
    __syncthreads();
    const LAS bf16* HN = (const LAS bf16*)CO;
    f32x4 acc[2][4];
#pragma unroll
    for (int a = 0; a < 2; ++a)
#pragma unroll
        for (int b = 0; b < 4; ++b) acc[a][b] = (f32x4){0.f, 0.f, 0.f, 0.f};
#define CV_MMA(src, s) do { _Pragma("unroll") for (int ks = 0; ks < 4; ++ks) { const bf16x8 a0 = ldsfrag(HN + r * 1032 + ((s) * 4 + ks) * 32 + q * 8), a1 = ldsfrag(HN + (16 + r) * 1032 + ((s) * 4 + ks) * 32 + q * 8); \
        _Pragma("unroll") for (int b = 0; b < 4; ++b) { acc[0][b] = mfma16(src[ks][b], a0, acc[0][b]); acc[1][b] = mfma16(src[ks][b], a1, acc[1][b]); } } } while (0)
    CV_MMA(wA, 0); CV_LOAD(wA, 2); CV_MMA(wB, 1); CV_LOAD(wB, 3); CV_MMA(wA, 2); CV_MMA(wB, 3);
#undef CV_LOAD
#undef CV_MMA
#pragma unroll
    for (int a = 0; a < 2; ++a) { bf16* yp = P.Y + (size_t)(m0 + a * 16 + r) * D + Y_B + n0 + 16 * q;
        const f32x4 v0 = acc[a][0] + pb0, v1 = acc[a][1] + pb1, v2 = acc[a][2] + pb2, v3 = acc[a][3] + pb3;
        v4u o0, o1; o0.x = pk2(v0.x, v0.y); o0.y = pk2(v0.z, v0.w); o0.z = pk2(v1.x, v1.y); o0.w = pk2(v1.z, v1.w); o1.x = pk2(v2.x, v2.y); o1.y = pk2(v2.z, v2.w); o1.z = pk2(v3.x, v3.y); o1.w = pk2(v3.z, v3.w);
        *(v4u*)yp = o0; *(v4u*)(yp + 8) = o1; }
}

__device__ __forceinline__ void sgu_unit(Frame& F, int l, int u) {
    __syncthreads();
    const Ptrs P = load_ptrs(F); const Ids I = fresh_ids(F); LAS unsigned char* const L = fresh_lds(F.lds);
    LAS unsigned char* VI = L + RING_OFF;
    LAS bf16* RAWV = (LAS bf16*)(L + RING_OFF + 65536);
    const int hp = u & 1, ck = u >> 1, m0 = ck * 128;
    {
        float lg[8], lb[8];
        { const f32x4 g0 = *(const f32x4*)(P.sln_g + (size_t)l * 512 + I.lane * 8), g1 = *(const f32x4*)(P.sln_g + (size_t)l * 512 + I.lane * 8 + 4);
          const f32x4 b0 = *(const f32x4*)(P.sln_b + (size_t)l * 512 + I.lane * 8), b1 = *(const f32x4*)(P.sln_b + (size_t)l * 512 + I.lane * 8 + 4);
          lg[0] = g0.x; lg[1] = g0.y; lg[2] = g0.z; lg[3] = g0.w; lg[4] = g1.x; lg[5] = g1.y; lg[6] = g1.z; lg[7] = g1.w;
          lb[0] = b0.x; lb[1] = b0.y; lb[2] = b0.z; lb[3] = b0.w; lb[4] = b1.x; lb[5] = b1.y; lb[6] = b1.z; lb[7] = b1.w; }
        v4u rw[16];
#pragma unroll
        for (int i = 0; i < 16; ++i) { const int it = I.tid + 512 * i; rw[i] = *(const v4u*)(P.PROJ + (size_t)(m0 + (it >> 6)) * PN + C_SV + (it & 63) * 8); }
#pragma unroll
        for (int hf = 0; hf < 2; ++hf) {
            if (hf) __syncthreads();
#pragma unroll
            for (int i = 0; i < 8; ++i) { const int it = I.tid + 512 * i; *(LAS v4u*)(RAWV + (it >> 6) * 512 + (it & 63) * 8) = rw[hf * 8 + i]; }
            __syncthreads();
#pragma unroll 1
            for (int i = 0; i < 8; i += 2) { const int rl = I.wave * 8 + i, s = hf * 64 + rl;
                float x0[8], x1[8]; { const v4u w0 = *(const LAS v4u*)(RAWV + rl * 512 + I.lane * 8), w1 = *(const LAS v4u*)(RAWV + (rl + 1) * 512 + I.lane * 8); unpack8(w0, x0); unpack8(w1, x1); }
                float s0 = 0.f, q0 = 0.f, s1 = 0.f, q1 = 0.f;
#pragma unroll
                for (int e = 0; e < 8; ++e) {   s0 += x0[e]; q0 += x0[e] * x0[e]; s1 += x1[e]; q1 += x1[e] * x1[e]; }
#pragma unroll
                for (int o = 1; o < 64; o <<= 1) { s0 += __shfl_xor(s0, o); q0 += __shfl_xor(q0, o); s1 += __shfl_xor(s1, o); q1 += __shfl_xor(q1, o); }
                const float mean0 = s0 * (1.0f / 512.0f), mean1 = s1 * (1.0f / 512.0f);
                const float rstd0 = rsq_(fmaxf(q0 * (1.0f / 512.0f) - mean0 * mean0, 0.f) + EPS), rstd1 = rsq_(fmaxf(q1 * (1.0f / 512.0f) - mean1 * mean1, 0.f) + EPS);
                if ((I.lane >> 5) == hp) { const int hh = (I.lane & 31) >> 4, chn = I.lane & 15;
                    float y0[8], y1[8];
#pragma unroll
                    for (int e = 0; e < 8; ++e) { y0[e] = (x0[e] - mean0) * rstd0 * lg[e] + lb[e]; y1[e] = (x1[e] - mean1) * rstd1 * lg[e] + lb[e]; }
                    v4u o0, o1; o0.x = pk2(y0[0], y0[1]); o0.y = pk2(y0[2], y0[3]); o0.z = pk2(y0[4], y0[5]); o0.w = pk2(y0[6], y0[7]); o1.x = pk2(y1[0], y1[1]); o1.y = pk2(y1[2], y1[3]); o1.z = pk2(y1[4], y1[5]); o1.w = pk2(y1[6], y1[7]);
                    *(LAS v4u*)(VI + hh * 32768 + imgb_off(s, chn)) = o0; *(LAS v4u*)(VI + hh * 32768 + imgb_off(s + 1, chn)) = o1; }
            }
        }
    }
    __syncthreads();
    const int r = I.lane & 15, q = I.lane >> 4, t0 = I.wave * 16, t = t0 + r;
    bf16x8 wfa[2][4]; v2u uua[2][8]; float bsa[2];
#pragma unroll
    for (int hh = 0; hh < 2; ++hh) { const int h = 2 * hp + hh;
        const bf16* Ws = P.WsM + (size_t)(l * 4 + h) * 128 * 128 + (size_t)t * 128 + q * 8;
        const bf16* urow = P.PROJ + (size_t)(m0 + t) * PN + C_SU + h * 128 + 4 * q;
#pragma unroll
        for (int ks = 0; ks < 4; ++ks) wfa[hh][ks] = glbfrag(Ws + ks * 32);
#pragma unroll
        for (int c = 0; c < 8; ++c) uua[hh][c] = *(const v2u*)(urow + 16 * c);
        bsa[hh] = P.sgu_b[(size_t)(l * 4 + h) * 128 + t]; }
#pragma unroll
    for (int hh = 0; hh < 2; ++hh) { const int h = 2 * hp + hh;
        const bf16x8 (&wf)[4] = wfa[hh]; const v2u (&uu)[8] = uua[hh]; const float bs = bsa[hh];
        f32x4 G[8];
#pragma unroll
        for (int c = 0; c < 8; ++c) G[c] = (f32x4){0.f, 0.f, 0.f, 0.f};
#pragma unroll
        for (int ks = 0; ks < 4; ++ks)
#pragma unroll
            for (int c = 0; c < 8; ++c) G[c] = mfma16(trfrag(VI + hh * 32768, I.lane, c, ks), wf[ks], G[c]);
        bf16* yrow = P.Y + (size_t)(m0 + t) * D + Y_C + h * 128 + 4 * q;
#pragma unroll
        for (int c = 0; c < 8; ++c) { const float uv[4] = {bflo(uu[c].x), bfhi(uu[c].x), bflo(uu[c].y), bfhi(uu[c].y)};
            v2u o; o.x = pk2(uv[0] * (G[c][0] + bs), uv[1] * (G[c][1] + bs)); o.y = pk2(uv[2] * (G[c][2] + bs), uv[3] * (G[c][3] + bs));
            *(v2u*)(yrow + 16 * c) = o; }
    }
}

__device__ __forceinline__ void ssd_dt(Frame& F, const Ptrs& P, int l, int m0, int g, LAS float* acs, LAS float* dts, LAS float* tot) {
    const Ids I = fresh_ids(F);
    const int hh = I.tid >> 7, li = I.tid & 127, head = 4 * g + hh, half = I.wave & 1;
    const float dtr = P.DT[(size_t)(m0 + li) * 8 + head] + P.ssm_dtb[l * 8 + head];
    const float dtv = fmaxf(dtr, 0.f) + log1pf(expf(-fabsf(dtr)));
    float v = dtv * -expf(P.ssm_alog[l * 8 + head]);
#pragma unroll
    for (int o = 1; o < 64; o <<= 1) { const float t = __shfl_up(v, o); if (I.lane >= o) v += t; }
    if (I.lane == 63) tot[I.wave] = v;
    __syncthreads();
    if (half) v += tot[I.wave - 1];
    acs[hh * 128 + li] = v; dts[hh * 128 + li] = dtv;
    __syncthreads();
}
__device__ __forceinline__ void conv4_item(const Ptrs& P, int l, int m, int pos, int ch0, float (&o)[8]) {
    const float* cb = P.ssm_cb + (size_t)l * 1024 + ch0; const float* cw = P.ssm_cw + (size_t)l * 4096 + ch0;
    { const f32x4 b0 = *(const f32x4*)cb, b1 = *(const f32x4*)(cb + 4); o[0] = b0.x; o[1] = b0.y; o[2] = b0.z; o[3] = b0.w; o[4] = b1.x; o[5] = b1.y; o[6] = b1.z; o[7] = b1.w; }
#pragma unroll
    for (int k = 0; k < 4; ++k) if (pos - 3 + k >= 0) {
        const v4u w = *(const v4u*)(P.PROJ + (size_t)(m - 3 + k) * PN + C_XBC + ch0); float x[8]; unpack8(w, x);
        const f32x4 w0 = *(const f32x4*)(cw + k * 1024), w1 = *(const f32x4*)(cw + k * 1024 + 4);
        o[0] += w0.x * x[0]; o[1] += w0.y * x[1]; o[2] += w0.z * x[2]; o[3] += w0.w * x[3]; o[4] += w1.x * x[4]; o[5] += w1.y * x[5]; o[6] += w1.z * x[6]; o[7] += w1.w * x[7]; }
#pragma unroll
    for (int e = 0; e < 8; ++e) o[e] = siluf_(o[e]);
}
constexpr int SA_BI = 0, SA_XI = 32768, SA_ACS = 98304, SA_DTS = 100352, SA_TOT = 102400;
constexpr int SSD_CM = 0, SSD_BM = 34816, SSD_XI = 69632, SSD_ACS = 135168, SSD_DTS = 137216;
static_assert(SSD_DTS + 2048 <= RING_BYTES && SA_TOT + 64 <= RING_BYTES, "SSD LDS map");
__device__ __forceinline__ void ssdA_unit(Frame& F, int l, int u) {
    __syncthreads();
    const Ptrs P = load_ptrs(F); const Ids I = fresh_ids(F); LAS unsigned char* const L = fresh_lds(F.lds);
    LAS unsigned char* BI = L + RING_OFF + SA_BI;
    LAS unsigned char* XI = L + RING_OFF + SA_XI;
    LAS float* acs = (LAS float*)(L + RING_OFF + SA_ACS); LAS float* dts = (LAS float*)(L + RING_OFF + SA_DTS); LAS float* tot = (LAS float*)(L + RING_OFF + SA_TOT);
    const int g = u & 1, ck = u >> 1, b = ck >> 6, c = ck & 63, m0 = ck * 128, pos0 = c * 128;
    ssd_dt(F, P, l, m0, g, acs, dts, tot);
    { float* ag = P.ACS + (size_t)u * 1024; ag[I.tid] = acs[I.tid]; ag[512 + I.tid] = dts[I.tid]; }
    if (I.tid < 4) P.CD[(size_t)(b * NCH + c) * 8 + 4 * g + I.tid] = exp_(acs[I.tid * 128 + 127]);
#pragma unroll 4
    for (int i = 0; i < 16; ++i) {
        const int it = I.tid + 512 * i; int li, cg, ch0;
        if (i < 8) { li = it >> 5; cg = it & 31; ch0 = g * 256 + cg * 8; }
        else { const int j = it - (i < 12 ? 4096 : 6144); li = j >> 4; cg = j & 15; ch0 = (i < 12 ? 512 : 768) + g * 128 + cg * 8; }
        float o[8]; conv4_item(P, l, m0 + li, pos0 + li, ch0, o);
        v4u w; w.x = pk2(o[0], o[1]); w.y = pk2(o[2], o[3]); w.z = pk2(o[4], o[5]); w.w = pk2(o[6], o[7]);
        *(v4u*)(P.XBC + (size_t)(m0 + li) * 1024 + ch0) = w;
        if (i < 8) { const int hh = cg >> 3; const float fac = dts[hh * 128 + li] * exp_(acs[hh * 128 + 127] - acs[hh * 128 + li]);
            v4u ws; ws.x = pk2(o[0] * fac, o[1] * fac); ws.y = pk2(o[2] * fac, o[3] * fac); ws.z = pk2(o[4] * fac, o[5] * fac); ws.w = pk2(o[6] * fac, o[7] * fac);
            *(LAS v4u*)(XI + (hh >> 1) * 32768 + imgb_off(li, cg & 15)) = ws; }
        else if (i < 12) *(LAS v4u*)(BI + imgb_off(li, cg)) = w;
    }
    __syncthreads();
    const int r = I.lane & 15, q = I.lane >> 4, hh = I.wave >> 1, ph = (I.wave & 1) * 32;
    const LAS unsigned char* XIh = XI + (hh >> 1) * 32768; const int cx = (hh & 1) * 4 + (ph >> 4);
    f32x4 acc[2][8];
#pragma unroll
    for (int a = 0; a < 2; ++a)
#pragma unroll
        for (int n = 0; n < 8; ++n) acc[a][n] = (f32x4){0.f, 0.f, 0.f, 0.f};
#pragma unroll
    for (int ks = 0; ks < 4; ++ks) { const bf16x8 x0 = trfrag(XIh, I.lane, cx, ks), x1 = trfrag(XIh, I.lane, cx + 1, ks);
#pragma unroll
        for (int n = 0; n < 8; ++n) { const bf16x8 bn = trfrag(BI, I.lane, n, ks); acc[0][n] = mfma16(bn, x0, acc[0][n]); acc[1][n] = mfma16(bn, x1, acc[1][n]); } }
    float* st = P.STATES + ((size_t)((b * NCH + c) * 8 + 4 * g + hh) * 64) * 128;
#pragma unroll
    for (int a = 0; a < 2; ++a)
#pragma unroll
        for (int n = 0; n < 8; ++n) *(f32x4*)(st + (size_t)(ph + a * 16 + r) * 128 + n * 16 + 4 * q) = acc[a][n];
}
__device__ __forceinline__ void ssd_scan(Frame& F) {
    const Ptrs P = load_ptrs(F); const Ids I = fresh_ids(F);
    const int gt = fresh_bid() * (NWAVES * 64) + I.tid, NGT = F.G * NWAVES * 64;
#pragma unroll 1
    for (int e = gt; e < BATCH * 8 * 64 * 128; e += NGT) { const int pn = e & 8191, h = (e >> 13) & 7, b = e >> 16;
        float hs = 0.f;
#pragma unroll 1
        for (int c0 = 0; c0 < NCH; c0 += 32) {
            float sv[32], cd[32];
#pragma unroll
            for (int c = 0; c < 32; ++c) { sv[c] = P.STATES[((size_t)((b * NCH + c0 + c) * 8 + h) * 8192) + pn]; cd[c] = P.CD[(size_t)(b * NCH + c0 + c) * 8 + h]; }
#pragma unroll
            for (int c = 0; c < 32; ++c) { P.PREV[((size_t)((b * NCH + c0 + c) * 8 + h) * 8192) + pn] = (bf16)f2bf(hs); hs = hs * cd[c] + sv[c]; }
        }
    }
}
__device__ __forceinline__ void ssdC_unit(Frame& F, int l, int u) {
    __syncthreads();
    const Ptrs P = load_ptrs(F); const Ids I = fresh_ids(F); LAS unsigned char* const L = fresh_lds(F.lds);
    LAS bf16* CM = (LAS bf16*)(L + RING_OFF + SSD_CM);
    LAS bf16* BM = (LAS bf16*)(L + RING_OFF + SSD_BM);
    LAS unsigned char* XI = L + RING_OFF + SSD_XI;
    LAS float* acs = (LAS float*)(L + RING_OFF + SSD_ACS); LAS float* dts = (LAS float*)(L + RING_OFF + SSD_DTS);
    const int g = u & 1, ck = u >> 1, b = ck >> 6, c = ck & 63, m0 = ck * 128;
    const float dsk0 = P.ssm_d[l * 8 + 4 * g], dsk1 = P.ssm_d[l * 8 + 4 * g + 1], dsk2 = P.ssm_d[l * 8 + 4 * g + 2], dsk3 = P.ssm_d[l * 8 + 4 * g + 3];
    { const float* ag = P.ACS + (size_t)u * 1024; acs[I.tid] = ag[I.tid]; dts[I.tid] = ag[512 + I.tid]; }
    {
        v4u w[16];
#pragma unroll
        for (int i = 0; i < 16; ++i) { const int it = I.tid + 512 * i; int li, ch0;
            if (i < 8) { li = it >> 5; ch0 = g * 256 + (it & 31) * 8; } else { const int j = it - (i < 12 ? 4096 : 6144); li = j >> 4; ch0 = (i < 12 ? 512 : 768) + g * 128 + (j & 15) * 8; }
            w[i] = *(const v4u*)(P.XBC + (size_t)(m0 + li) * 1024 + ch0); }
#pragma unroll
        for (int i = 0; i < 16; ++i) { const int it = I.tid + 512 * i;
            if (i < 8) { const int li = it >> 5, cg = it & 31; *(LAS v4u*)(XI + (cg >> 4) * 32768 + imgb_off(li, cg & 15)) = w[i]; }
            else { const int j = it - (i < 12 ? 4096 : 6144), li = j >> 4, cg = j & 15; *(LAS v4u*)((i < 12 ? BM : CM) + li * 136 + cg * 8) = w[i]; } }
    }
    __syncthreads();
    const int grp = I.wave < 4 ? I.wave : 11 - I.wave;
    const int r = I.lane & 15, q = I.lane >> 4, l0 = grp * 16, li = l0 + r;
    bf16x8 cf[4]; f32x4 cb[8];
#pragma unroll
    for (int n = 0; n < 8; ++n) cb[n] = (f32x4){0.f, 0.f, 0.f, 0.f};
#pragma unroll
    for (int ks = 0; ks < 4; ++ks) { cf[ks] = ldsfrag(CM + li * 136 + ks * 32 + q * 8);
#pragma unroll
        for (int n = 0; n < 8; ++n) if (n <= grp) cb[n] = mfma16(ldsfrag(BM + (n * 16 + r) * 136 + ks * 32 + q * 8), cf[ks], cb[n]); }
    __syncthreads();
    LAS bf16* Sw = BM + l0 * 136;
    float ssq = 0.f;
    const bf16* zrow = P.PROJ + (size_t)(m0 + li) * PN + C_Z + g * 256 + 4 * q;
    bf16* yrow = P.Y + (size_t)(m0 + li) * D + Y_D + g * 256 + 4 * q;
    const bf16* pv0 = P.PREV + ((size_t)((b * NCH + c) * 8 + 4 * g) * 64) * 128 + (size_t)r * 128 + q * 8;
    bf16x8 pf[4][4]; v2u zf[4];
#pragma unroll
    for (int cc = 0; cc < 4; ++cc) { zf[cc] = *(const v2u*)(zrow + cc * 16);
#pragma unroll
        for (int ks = 0; ks < 4; ++ks) pf[cc][ks] = glbfrag(pv0 + (size_t)cc * 16 * 128 + ks * 32); }
#pragma unroll 1
    for (int hh = 0; hh < 4; ++hh) { const int head = 4 * g + hh;
        bf16x8 cpf[4][4]; v2u czf[4];
#pragma unroll
        for (int cc = 0; cc < 4; ++cc) { czf[cc] = zf[cc];
#pragma unroll
            for (int ks = 0; ks < 4; ++ks) cpf[cc][ks] = pf[cc][ks]; }
        if (hh < 3) { const bf16* pvn = pv0 + (size_t)(hh + 1) * 64 * 128;
#pragma unroll
            for (int cc = 0; cc < 4; ++cc) { zf[cc] = *(const v2u*)(zrow + (hh + 1) * 64 + cc * 16);
#pragma unroll
                for (int ks = 0; ks < 4; ++ks) pf[cc][ks] = glbfrag(pvn + (size_t)cc * 16 * 128 + ks * 32); } }
        const float al = acs[hh * 128 + li];
        f32x4 yv[4];
#pragma unroll
        for (int cc = 0; cc < 4; ++cc) yv[cc] = (f32x4){0.f, 0.f, 0.f, 0.f};
#pragma unroll
        for (int ks = 0; ks < 4; ++ks)
#pragma unroll
            for (int cc = 0; cc < 4; ++cc) yv[cc] = mfma16(cpf[cc][ks], cf[ks], yv[cc]);
        { const float ea = exp_(al);
#pragma unroll
          for (int cc = 0; cc < 4; ++cc) yv[cc] = yv[cc] * ea; }
#pragma unroll
        for (int n = 0; n < 8; ++n) { const int s0 = n * 16 + 4 * q;
            if (n <= grp) { const f32x4 as4 = *(const LAS f32x4*)(acs + hh * 128 + s0), ds4 = *(const LAS f32x4*)(dts + hh * 128 + s0);
                float v[4];
#pragma unroll
                for (int jj = 0; jj < 4; ++jj) v[jj] = (s0 + jj <= li) ? cb[n][jj] * exp_(fminf(al - as4[jj], 0.f)) * ds4[jj] : 0.f;
                v2u sw; sw.x = pk2(v[0], v[1]); sw.y = pk2(v[2], v[3]); *(LAS v2u*)(Sw + r * 136 + s0) = sw; }
            else if (n == grp + 1 && (n & 1)) *(LAS v2u*)(Sw + r * 136 + s0) = (v2u){0u, 0u}; }
        asm volatile("" ::: "memory");
        const LAS unsigned char* XIh = XI + (hh >> 1) * 32768;
#pragma unroll
        for (int ks = 0; ks < 4; ++ks) if (2 * ks <= grp) { const bf16x8 sa = ldsfrag(Sw + r * 136 + ks * 32 + q * 8);
#pragma unroll
            for (int cc = 0; cc < 4; ++cc) yv[cc] = mfma16(trfrag(XIh, I.lane, (hh & 1) * 4 + cc, ks), sa, yv[cc]); }
        asm volatile("" ::: "memory");
        const float dsk = hh == 0 ? dsk0 : hh == 1 ? dsk1 : hh == 2 ? dsk2 : dsk3;
#pragma unroll
        for (int cc = 0; cc < 4; ++cc) { const int pc = (hh & 1) * 64 + cc * 16 + 4 * q;
            const v2u xw = *(const LAS v2u*)(XIh + imgb_off(li, pc >> 3) + (pc & 7) * 2);
            const float xs[4] = {bflo(xw.x), bfhi(xw.x), bflo(xw.y), bfhi(xw.y)}, zz[4] = {bflo(czf[cc].x), bfhi(czf[cc].x), bflo(czf[cc].y), bfhi(czf[cc].y)};
            float yo[4];
#pragma unroll
            for (int jj = 0; jj < 4; ++jj) { yo[jj] = (yv[cc][jj] + xs[jj] * dsk) * zz[jj];     ssq += yo[jj] * yo[jj]; }
            v2u yw; yw.x = pk2(yo[0], yo[1]); yw.y = pk2(yo[2], yo[3]); *(v2u*)(yrow + hh * 64 + cc * 16) = yw; }
    }
    ssq += __shfl_xor(ssq, 16); ssq += __shfl_xor(ssq, 32);
    const float rs = rsq_(ssq * (1.0f / 256.0f) + EPS);
    asm volatile("s_waitcnt vmcnt(0)" ::: "memory");
    const float* ngp = P.ssm_norm + (size_t)l * 512 + g * 256 + 4 * q;
#pragma unroll
    for (int k = 0; k < 16; ++k) { const v2u yw = *(const v2u*)(yrow + k * 16); const f32x4 ng = *(const f32x4*)(ngp + k * 16);
        v2u o; o.x = pk2(bflo(yw.x) * rs * ng.x, bfhi(yw.x) * rs * ng.y); o.y = pk2(bflo(yw.y) * rs * ng.z, bfhi(yw.y) * rs * ng.w); *(v2u*)(yrow + k * 16) = o; }
}

struct Args { const float* in[31]; float* out; unsigned char* ws; };
__global__ void __launch_bounds__(NWAVES * 64, 2) mk_fwd(Args args) {
    extern __shared__ __attribute__((aligned(16))) unsigned char lds[];
    Frame F;
    F.lds = (LAS unsigned char*)lds;
    F.MISC = (volatile LAS unsigned*)(F.lds + MISC_OFF);
    F.G = gridDim.x; F.wave0 = __builtin_amdgcn_readfirstlane((int)(threadIdx.x >> 6));
    F.ctl = (gu32*)(args.ws + WS_CTL);
    for (int u = threadIdx.x; u < (LDS_BYTES - LDSCTL_OFF) / 4; u += NWAVES * 64) ((LAS unsigned*)(F.lds + LDSCTL_OFF))[u] = 0u;
    __syncthreads();
    if (threadIdx.x == 0) {
        LAS unsigned long long* tb = (LAS unsigned long long*)(F.lds + PTR_OFF);
#pragma unroll
        for (int i = 0; i < 31; ++i) tb[i] = (unsigned long long)args.in[i];
        tb[31] = (unsigned long long)args.out; tb[32] = (unsigned long long)args.ws;
    }
    __syncthreads();
    (void)xcd_barrier_post((unsigned*)(F.ctl + CW_BAR), F.MISC + 8);
#define GRID_BAR() do { XcdBarrier bb_; unsigned long long bp_ = (unsigned long long)(F.ctl + CW_BAR); asm volatile("" : "+s"(bp_)); bb_.bar = (unsigned*)(GAS unsigned*)bp_; bb_.x = xb_xcc_id(); bb_.st = F.MISC + 8; bb_.w0 = F.wave0; xcd_barrier(bb_); } while (0)

    prologue_weights(F);
    { const Ptrs P = load_ptrs(F); row_phase<RP_FIRST>(F, P.x, P.H, P.SS, nullptr, nullptr, nullptr, nullptr); }
    GRID_BAR();
    {
        unsigned* cb_ = (unsigned*)(GAS unsigned*)(unsigned long long)(F.ctl + CW_BAR); bool even = (F.G % 8 == 0);
#pragma unroll
        for (int j = 0; j < 16; ++j) even = even && (xb_ld(&cb_[XB_XCNT(j)]) == (j < 8 ? (unsigned)F.G / 8u : 0u));
        const int rank = (int)F.MISC[10], xcc = (int)xb_xcc_id();
        F.vb = __builtin_amdgcn_readfirstlane(even ? rank * 8 + xcc : (int)blockIdx.x);
    }

#define FILL_ROWSCALE(ssp, S) \
    LAS float* rt_ = (LAS float*)(F.lds + RING_OFF + pg8::STAGE_BYTES);     \
    pg8::Unit u0_; u0_.pm = 0; u0_.pn = 0; (void)S.next(0, u0_); \
    const pg8::FillRow PF_{ssp, rt_, u0_.pm};     \
    const pg8::RowScale R_{ssp, rt_, u0_.pm};
#pragma unroll 1
    for (int it = 0; it < 3 * NL; ++it) {
        const int l = it / 3, kind = it - 3 * l, f = kind >> 1;
        if (kind != 1) {
            const Ptrs P = load_ptrs(F);
            pg8::Gemm g{P.H, P.Wgu + (size_t)(l * 2 + f) * (2 * FF) * D, M, 2 * FF, D}; pg8::StaticOrder S; S.init(M, 2 * FF, F.G, fresh_vb(F));
            const unsigned long long* ssp = P.SS + (size_t)it * M;
            FILL_ROWSCALE(ssp, S)
            pg8::EpiSwiGLU E{P.ACT, FF, R_};
            pg8::gemm_phase<pg8::EpiSwiGLU, pg8::StaticOrder, true, true, pg8::FillRow>(F.lds + RING_OFF, g, S, E, F.wave0, PF_);
            GRID_BAR();
        } else {
            {
                const Ptrs P = load_ptrs(F);
                dt_phase(F, l, P.SS + (size_t)it * M);
                pg8::Gemm g{P.H, P.Win + (size_t)l * PN * D, M, PN, D}; pg8::StaticOrder S; S.init(M, PN, F.G, fresh_vb(F));
                const unsigned long long* ssp = P.SS + (size_t)it * M;
                FILL_ROWSCALE(ssp, S)
                pg8::EpiBf16Rs E{P.PROJ, PN, R_};
                pg8::gemm_phase<pg8::EpiBf16Rs, pg8::StaticOrder, true, true, pg8::FillRow>(F.lds + RING_OFF, g, S, E, F.wave0, PF_);
                GRID_BAR();
            }
            for (int u = fresh_bid(); u < 256; u += F.G) ssdA_unit(F, l, u);
            for (int u = fresh_bid(); u < 512; u += F.G) conv_unit<0>(F, l, u);
            for (int u = fresh_bid(); u < 256; u += F.G) sgu_unit(F, l, u);
            for (int u = fresh_bid(); u < 256; u += F.G) pool_unit(F, l, u);
            GRID_BAR();
            ssd_scan(F);
            GRID_BAR();
            for (int u = fresh_bid(); u < 256; u += F.G) ssdC_unit(F, l, u);
            GRID_BAR();
        }
        {
            const Ptrs P = load_ptrs(F);
            const bf16* A = kind != 1 ? P.ACT : P.Y; const bf16* Bt = kind != 1 ? P.Wd + (size_t)(l * 2 + f) * D * FF : P.Wout + (size_t)l * D * D;
            pg8::Gemm g{A, Bt, M, D, kind != 1 ? FF : D}; pg8::StaticOrder S; S.init(M, D, F.G, fresh_vb(F), 4);
            pg8::EpiResAdd E{P.H, D, kind != 1 ? 0.5f : 1.0f, it + 1 < 3 * NL ? P.SS + (size_t)(it + 1) * M : nullptr};
            pg8::gemm_phase<pg8::EpiResAdd, pg8::StaticOrder, true, true>(F.lds + RING_OFF, g, S, E, F.wave0);
            GRID_BAR();
        }
    }
#undef FILL_ROWSCALE
    { const Ptrs P = load_ptrs(F); row_phase<RP_FINAL>(F, nullptr, P.H, nullptr, P.final_norm, P.X, nullptr, nullptr); }
}

extern "C" void kernel_launch(void* const* d_in, const int* in_sizes, int n_in, void* d_out, int out_size, void* d_ws, size_t ws_size, hipStream_t stream) {
    static int grid = 0;
    if (grid == 0) {
        if (n_in != 31 || in_sizes[0] != M * D || out_size != M * D || ws_size < WS_END) { fprintf(stderr, "kernel_launch: unexpected shapes (n_in %d, in0 %d, out %d, ws %zu < %zu); nothing launched\n", n_in, n_in > 0 ? in_sizes[0] : -1, out_size, ws_size, (size_t)WS_END); grid = -1; return; }
        int dev = 0, cus = 0, per_cu = 0;
        if (hipGetDevice(&dev) != hipSuccess || hipDeviceGetAttribute(&cus, hipDeviceAttributeMultiprocessorCount, dev) != hipSuccess) { fprintf(stderr, "kernel_launch: device query failed\n"); grid = -1; return; }
        if (hipFuncSetAttribute((const void*)mk_fwd, hipFuncAttributeMaxDynamicSharedMemorySize, LDS_BYTES) != hipSuccess) { fprintf(stderr, "kernel_launch: hipFuncSetAttribute failed\n"); grid = -1; return; }
        if (hipOccupancyMaxActiveBlocksPerMultiprocessor(&per_cu, (const void*)mk_fwd, NWAVES * 64, LDS_BYTES) != hipSuccess || per_cu < 1) { fprintf(stderr, "kernel_launch: occupancy query reports %d blocks per CU\n", per_cu); }
        (void)hipGetLastError();
        grid = cus;
    }
    if (grid < 0) return;
    if (hipMemsetAsync((char*)d_ws + WS_CTL, 0, CTL_ZERO_BYTES, stream) != hipSuccess) { fprintf(stderr, "kernel_launch: memset failed\n"); return; }
    Args a{};
    for (int i = 0; i < 31; ++i) a.in[i] = (const float*)d_in[i];
    a.out = (float*)d_out; a.ws = (unsigned char*)d_ws;
    hipLaunchKernelGGL(mk_fwd, dim3(grid), dim3(NWAVES * 64), LDS_BYTES, stream, a);
    const hipError_t le = hipPeekAtLastError();
    if (le != hipSuccess) fprintf(stderr, "kernel_launch: launch failed: %s\n", hipGetErrorName(le));
}
```
